# Optimizing an MI355X kernel written in HIP

```python
import jax, jax.numpy as jnp
from jax import lax
import numpy as np

D_MODEL = 1024
BATCH = 8
SEQ = 2048
DEPTH = 1

D_PLE = 256
D_FF = 2816
MLSTM_HEADS = 4
MLSTM_HEAD_DIM = 128
MLSTM_WIDTH = MLSTM_HEADS * MLSTM_HEAD_DIM
GMLP_HEADS = 4
GMLP_HEAD_DIM = 128
GMLP_WIDTH = GMLP_HEADS * GMLP_HEAD_DIM
MIX_WIDTH = MLSTM_WIDTH + GMLP_WIDTH
CHUNK = 128
CONV_WIDTH = 4
N_NORMS = 8
EPS = 1e-6
IN_COLS = 4 * MLSTM_WIDTH + 2 * MLSTM_HEADS + 2 * GMLP_WIDTH

kernel_name = "hybrid_mlstm_gmlp_macaron_block"


def rms_norm(x, g):
    xf = x.astype(jnp.float32)
    y = xf * lax.rsqrt(jnp.mean(xf * xf, axis=-1, keepdims=True) + EPS)
    return (y * g.astype(jnp.float32)).astype(x.dtype)


def layer_norm(x, g, b):
    xf = x.astype(jnp.float32)
    mu = jnp.mean(xf, axis=-1, keepdims=True)
    var = jnp.mean(jnp.square(xf - mu), axis=-1, keepdims=True)
    y = (xf - mu) * lax.rsqrt(var + EPS)
    return (y * g.astype(jnp.float32) + b.astype(jnp.float32)).astype(x.dtype)


def swiglu(x, w_gu, w_down):
    g, u = jnp.split(x @ w_gu, 2, axis=-1)
    return (jax.nn.silu(g) * u) @ w_down


def causal_depthwise_conv(x, w, b):
    k_w, c = w.shape
    y = lax.conv_general_dilated(x, w[:, None, :], window_strides=(1,),
                                 padding=[(k_w - 1, 0)],
                                 dimension_numbers=('NWC', 'WIO', 'NWC'),
                                 feature_group_count=c)
    return y + b


def mlstm_chunkwise(q, k, v, log_i, log_f):
    bsz, nh, s, d = q.shape
    nc = s // CHUNK
    q = q.reshape(bsz, nh, nc, CHUNK, d)
    k = k.reshape(bsz, nh, nc, CHUNK, d)
    v = v.reshape(bsz, nh, nc, CHUNK, d)
    log_i = log_i.reshape(bsz, nh, nc, CHUNK)
    log_f = log_f.reshape(bsz, nh, nc, CHUNK)
    b = jnp.cumsum(log_f, axis=-1)
    a = b[..., -1]
    causal = jnp.tril(jnp.ones((CHUNK, CHUNK), dtype=bool))
    d_intra = jnp.where(causal, b[..., :, None] - b[..., None, :] + log_i[..., None, :], -jnp.inf)
    w_state = a[..., None] - b + log_i
    m_loc = jnp.max(w_state, axis=-1)
    e_state = jnp.exp(w_state - m_loc[..., None])
    ke = k * e_state[..., None]
    c_loc = jnp.einsum('bhcld,bhcle->bhcde', ke, v)
    n_loc = jnp.sum(ke, axis=3)

    def step(carry, xs):
        c_prev, n_prev, m_prev = carry
        a_c, m_l, c_l, n_l = xs
        m_new = jnp.maximum(a_c + m_prev, m_l)
        s_prev = jnp.exp(a_c + m_prev - m_new)
        s_loc = jnp.exp(m_l - m_new)
        c_new = s_prev[..., None, None] * c_prev + s_loc[..., None, None] * c_l
        n_new = s_prev[..., None] * n_prev + s_loc[..., None] * n_l
        return (c_new, n_new, m_new), (c_prev, n_prev, m_prev)

    init = (jnp.zeros((bsz, nh, d, d), jnp.float32),
            jnp.zeros((bsz, nh, d), jnp.float32),
            jnp.zeros((bsz, nh), jnp.float32))
    xs = (jnp.moveaxis(a, 2, 0), jnp.moveaxis(m_loc, 2, 0),
          jnp.moveaxis(c_loc, 2, 0), jnp.moveaxis(n_loc, 2, 0))
    _, (c_in, n_in, m_in) = lax.scan(step, init, xs)
    c_in = jnp.moveaxis(c_in, 0, 2)
    n_in = jnp.moveaxis(n_in, 0, 2)
    m_in = jnp.moveaxis(m_in, 0, 2)

    inter_log = b + m_in[..., None]
    m_t = jnp.maximum(inter_log, jnp.max(d_intra, axis=-1))
    e_inter = jnp.exp(inter_log - m_t)
    e_intra = jnp.exp(d_intra - m_t[..., None])
    qk = jnp.einsum('bhctd,bhcsd->bhcts', q, k) * e_intra
    num = (e_inter[..., None] * jnp.einsum('bhctd,bhcde->bhcte', q, c_in)
           + jnp.einsum('bhcts,bhcse->bhcte', qk, v))
    den = e_inter * jnp.einsum('bhctd,bhcd->bhct', q, n_in) + jnp.sum(qk, axis=-1)
    h = num / jnp.maximum(jnp.abs(den), jnp.exp(-m_t))[..., None]
    return h.reshape(bsz, nh, s, d)


def token_mixer(a, w_in, conv_w, conv_b, b_if, mh_norm_g, gmlp_ln_g, gmlp_ln_b,
                w_spatial, b_spatial, w_out):
    bsz, s, _ = a.shape
    mw, mh, md = MLSTM_WIDTH, MLSTM_HEADS, MLSTM_HEAD_DIM
    proj = a @ w_in
    qk_raw, v_m, o_pre, if_pre, u_g, v_g = jnp.split(
        proj, [2 * mw, 3 * mw, 4 * mw, 4 * mw + 2 * mh, 4 * mw + 2 * mh + GMLP_WIDTH], axis=-1)

    qk = jax.nn.silu(causal_depthwise_conv(qk_raw, conv_w, conv_b))
    q, k = jnp.split(qk, 2, axis=-1)

    def heads(t):
        return t.reshape(bsz, s, mh, md).transpose(0, 2, 1, 3).astype(jnp.float32)

    gates = (if_pre + b_if).astype(jnp.float32)
    log_i = gates[..., :mh].transpose(0, 2, 1)
    log_f = jax.nn.log_sigmoid(gates[..., mh:]).transpose(0, 2, 1)
    h = mlstm_chunkwise(heads(q), heads(k) * (md ** -0.5), heads(v_m), log_i, log_f)
    h = h.transpose(0, 2, 1, 3)
    h = h * lax.rsqrt(jnp.mean(h * h, axis=-1, keepdims=True) + EPS)
    h = h * mh_norm_g.reshape(mh, md).astype(jnp.float32)
    h_m = h.reshape(bsz, s, mw).astype(a.dtype) * jax.nn.sigmoid(o_pre)

    u_g = jax.nn.gelu(u_g, approximate=False)
    v_g = layer_norm(jax.nn.gelu(v_g, approximate=False), gmlp_ln_g, gmlp_ln_b)
    nc = s // CHUNK
    vc = v_g.reshape(bsz, nc, CHUNK, GMLP_HEADS, GMLP_HEAD_DIM)
    causal = jnp.tril(jnp.ones((CHUNK, CHUNK), dtype=bool))
    ws = jnp.where(causal, w_spatial, jnp.zeros_like(w_spatial))
    sv = jnp.einsum('gts,bcsge->bctge', ws, vc) + b_spatial.T[:, :, None]
    h_g = u_g * sv.reshape(bsz, s, GMLP_WIDTH)

    return jnp.concatenate([h_m, h_g], axis=-1) @ w_out


def setup_inputs(seed: int = 0) -> dict:
    key = jax.random.key(seed)
    ks = jax.random.split(key, 24)
    f32 = jnp.float32
    nrm = lambda k, shape, scale: (jax.random.normal(k, shape, f32) * scale)
    L = DEPTH
    x = nrm(ks[0], (BATCH, SEQ, D_MODEL), 1.0)
    p = nrm(ks[1], (L, BATCH, SEQ, D_PLE), 1.0)
    ffn1_gu = nrm(ks[2], (L, D_MODEL, 2 * D_FF), D_MODEL ** -0.5)
    ffn1_down = nrm(ks[3], (L, D_FF, D_MODEL), D_FF ** -0.5)
    ffn2_gu = nrm(ks[4], (L, D_MODEL, 2 * D_FF), D_MODEL ** -0.5)
    ffn2_down = nrm(ks[5], (L, D_FF, D_MODEL), D_FF ** -0.5)
    w_in = nrm(ks[6], (L, D_MODEL, IN_COLS), D_MODEL ** -0.5)
    conv_w = nrm(ks[7], (L, CONV_WIDTH, 2 * MLSTM_WIDTH), CONV_WIDTH ** -0.5)
    conv_b = nrm(ks[8], (L, 2 * MLSTM_WIDTH), 0.02)
    b_i = nrm(ks[9], (L, MLSTM_HEADS), 0.1)
    b_f = 3.0 + nrm(ks[10], (L, MLSTM_HEADS), 0.5)
    b_if = jnp.concatenate([b_i, b_f], axis=-1)
    mh_norm_g = 1.0 + nrm(ks[11], (L, MLSTM_WIDTH), 0.02)
    gmlp_ln_g = 1.0 + nrm(ks[12], (L, GMLP_WIDTH), 0.02)
    gmlp_ln_b = nrm(ks[13], (L, GMLP_WIDTH), 0.02)
    w_spatial = nrm(ks[14], (L, GMLP_HEADS, CHUNK, CHUNK), CHUNK ** -0.5)
    b_spatial = 1.0 + nrm(ks[15], (L, GMLP_HEADS, CHUNK), 0.1)
    w_out = nrm(ks[16], (L, MIX_WIDTH, D_MODEL), MIX_WIDTH ** -0.5)
    w_ple = nrm(ks[17], (L, D_PLE, D_MODEL), D_PLE ** -0.5)
    w_ple_gate = nrm(ks[18], (L, D_MODEL, D_MODEL), D_MODEL ** -0.5)
    norm_g = 1.0 + nrm(ks[19], (L, N_NORMS, D_MODEL), 0.02)
    return {"x": x, "p": p, "ffn1_gu": ffn1_gu, "ffn1_down": ffn1_down,
            "ffn2_gu": ffn2_gu, "ffn2_down": ffn2_down, "w_in": w_in,
            "conv_w": conv_w, "conv_b": conv_b, "b_if": b_if,
            "mh_norm_g": mh_norm_g, "gmlp_ln_g": gmlp_ln_g, "gmlp_ln_b": gmlp_ln_b,
            "w_spatial": w_spatial, "b_spatial": b_spatial, "w_out": w_out,
            "w_ple": w_ple, "w_ple_gate": w_ple_gate, "norm_g": norm_g}


def reference(x, p, ffn1_gu, ffn1_down, ffn2_gu, ffn2_down, w_in, conv_w, conv_b,
              b_if, mh_norm_g, gmlp_ln_g, gmlp_ln_b, w_spatial, b_spatial, w_out,
              w_ple, w_ple_gate, norm_g):
    h = x
    for i in range(DEPTH):
        g = norm_g[i]
        h = h + 0.5 * rms_norm(swiglu(rms_norm(h, g[0]), ffn1_gu[i], ffn1_down[i]), g[1])
        mix = token_mixer(rms_norm(h, g[2]), w_in[i], conv_w[i], conv_b[i], b_if[i],
                          mh_norm_g[i], gmlp_ln_g[i], gmlp_ln_b[i], w_spatial[i],
                          b_spatial[i], w_out[i])
        h = h + rms_norm(mix, g[3])
        h = h + 0.5 * rms_norm(swiglu(rms_norm(h, g[4]), ffn2_gu[i], ffn2_down[i]), g[5])
        gate = jax.nn.sigmoid(rms_norm(h, g[6]) @ w_ple_gate[i])
        h = h + rms_norm(gate * (p[i] @ w_ple[i]), g[7])
    return h
```

```cpp
#include <hip/hip_runtime.h>
#include <hip/hip_cooperative_groups.h>
#include <cstdio>
#include <cstdint>
namespace cg = cooperative_groups;
namespace pg8 {
#define PG8_LAS __attribute__((address_space(3)))
typedef unsigned short bf16_t;
typedef short bf16x8 __attribute__((ext_vector_type(8)));
typedef float f32x4 __attribute__((ext_vector_type(4)));
typedef unsigned u32x4 __attribute__((ext_vector_type(4)));
constexpr int BM = 256, BK = 64, HALF = 128, HTB = HALF * BK * 2  , STAGE_BYTES = 8 * HTB, NXCD = 8, WGM = 8;

__host__ __device__ __forceinline__ int lds_byte(int r, int c) { const int st = (r >> 4) * 2 + (c >> 5), rr = r & 15, cc = c & 31, ob = rr * 64 + cc * 2; return st * 1024 + (ob ^ (((ob >> 9) & 1) << 5)); }
__host__ __device__ __forceinline__ void stage_rc(int b, int& R, int& C) { const int st = b / 1024, sb = b % 1024, swz = sb ^ (((sb >> 9) & 1) << 5); R = (st >> 1) * 16 + swz / 64; C = (st & 1) * 32 + (swz % 64) / 2; }
__host__ __device__ __forceinline__ int perm32(int rho) { const int n = rho >> 4, i = rho & 15; return 8 * (i >> 2) + 4 * n + (i & 3); }

struct Unit { int pm, pn; };
struct Gemm { const bf16_t* A; const bf16_t* Bt; int M, N, K; int lda = 0; };

struct StaticOrder {
    int nM, nN, nwg, G, c;
    __host__ __device__ void init(int M, int N, int G_, int c_) { nM = M / BM; nN = N / BM; nwg = nM * nN; G = G_; c = c_; }
    __host__ __device__ bool next(int i, Unit& u) const {
        const long L = (long)i * G + c; if (L >= nwg) return false;
        int wgid = (int)L; { const int q = nwg / NXCD, r = nwg % NXCD, xcd = wgid % NXCD, off = wgid / NXCD; wgid = (xcd < r ? xcd * (q + 1) : r * (q + 1) + (xcd - r) * q) + off; }
        const int nig = WGM * nN, gid = wgid / nig, fm = gid * WGM, gsz = (nM - fm) < WGM ? (nM - fm) : WGM;
        u.pm = fm + ((wgid % nig) % gsz); u.pn = (wgid % nig) / gsz; return true;
    }
    __device__ __forceinline__ void a_ready(const Unit&) const {}
    __device__ __forceinline__ void done(const Unit&) const {}
};

typedef __bf16 bf16x2_t __attribute__((ext_vector_type(2)));
__device__ __forceinline__ unsigned cvt_pk_bf16(float lo, float hi) { typedef float f32x2_ __attribute__((ext_vector_type(2))); const f32x2_ v = {lo, hi}; return __builtin_bit_cast(unsigned, __builtin_convertvector(v, bf16x2_t)); }
typedef float f32x2 __attribute__((ext_vector_type(2)));
__device__ __forceinline__ f32x2 gelu_pk(f32x2 v) {
    const f32x2 av = __builtin_elementwise_abs(v), d = av * 0.2316418882f + 1.0f;
    f32x2 t; t.x = __builtin_amdgcn_rcpf(d.x); t.y = __builtin_amdgcn_rcpf(d.y);
    f32x2 q = t * 0.5307027145f + (-0.7265760135f); q = q * t + 0.7107068705f; q = q * t + (-0.142248368f); q = q * t + 0.127414796f; q = q * t;
    const f32x2 s = (v * v) * (-0.72134752044f);
    f32x2 e; e.x = __builtin_amdgcn_exp2f(s.x); e.y = __builtin_amdgcn_exp2f(s.y);
    const f32x2 m = v * (q * e), r = v - m;
    f32x2 o; o.x = v.x < 0.f ? m.x : r.x; o.y = v.y < 0.f ? m.y : r.y; return o;
}

__device__ __forceinline__ float fast_sigmoid(float x) { return __builtin_amdgcn_rcpf(1.0f + __expf(-x)); }

__device__ __forceinline__ void row_scales(float (&rs)[2][4], const float* ss, const Unit& u, int wr, int fr) {
#pragma unroll
    for (int ai = 0; ai < 2; ++ai)
#pragma unroll
        for (int m = 0; m < 4; ++m) {
            if (ss) { const f32x4 s = *(const f32x4*)(ss + (size_t)(u.pm * BM + ai * HALF + wr * 64 + m * 16 + fr) * 4); rs[ai][m] = 1.0f / sqrtf(((s[0] + s[1]) + (s[2] + s[3])) * (1.0f / 1024.0f) + 1e-6f); }
            else rs[ai][m] = 1.0f; }
}
struct EpiSwiglu {
    static constexpr bool PERM = true, AFTER_DRAIN = false;
    bf16_t* O; int ldc; const float* ss; mutable int cpm; mutable float rs[2][4];
    __device__ __forceinline__ void operator()(const f32x4 (&acc)[2][2][4][2], const Unit& u, int wr, int wc, int fr, int fq) const {
        const int row0 = u.pm * BM + wr * 64 + fr; const int col0 = u.pn * HALF + wc * 32 + 8 * fq;
        if (u.pm != cpm) { row_scales(rs, ss, u, wr, fr); cpm = u.pm; }
#pragma unroll
        for (int ai = 0; ai < 2; ++ai)
#pragma unroll
            for (int m = 0; m < 4; ++m) { bf16_t* rowp = O + (size_t)(row0 + ai * HALF + m * 16) * ldc + col0;
                float o[8];
#pragma unroll
                for (int n = 0; n < 2; ++n)
#pragma unroll
                    for (int j = 0; j < 4; ++j) { const float g = acc[ai][0][m][n][j] * rs[ai][m], uu = acc[ai][1][m][n][j] * rs[ai][m]; o[n * 4 + j] = g * fast_sigmoid(g) * uu; }
                u32x4 w; w.x = cvt_pk_bf16(o[0], o[1]); w.y = cvt_pk_bf16(o[2], o[3]); w.z = cvt_pk_bf16(o[4], o[5]); w.w = cvt_pk_bf16(o[6], o[7]);
                __builtin_nontemporal_store(w, (u32x4*)rowp); }
    }
};

struct EpiProj {
    static constexpr bool PERM = true, AFTER_DRAIN = false;
    bf16_t* O; int ldc; int gelu_pn_min; const float* ss; mutable int cpm; mutable float rs[2][4]; bool nt;
    __device__ __forceinline__ void operator()(const f32x4 (&acc)[2][2][4][2], const Unit& u, int wr, int wc, int fr, int fq) const {
        const int row0 = u.pm * BM + wr * 64 + fr; const int col0 = u.pn * BM + wc * 32 + 8 * fq;
        const bool act = u.pn >= gelu_pn_min;
        if (u.pm != cpm) { row_scales(rs, ss, u, wr, fr); cpm = u.pm; }
#pragma unroll
        for (int ai = 0; ai < 2; ++ai)
#pragma unroll
            for (int m = 0; m < 4; ++m) { bf16_t* rowp = O + (size_t)(row0 + ai * HALF + m * 16) * ldc + col0;
#pragma unroll
                for (int bj = 0; bj < 2; ++bj) { f32x4 v0 = acc[ai][bj][m][0] * rs[ai][m], v1 = acc[ai][bj][m][1] * rs[ai][m];
                    if (act) { f32x2 a = gelu_pk((f32x2){v0[0], v0[1]}), b = gelu_pk((f32x2){v0[2], v0[3]}), c = gelu_pk((f32x2){v1[0], v1[1]}), d = gelu_pk((f32x2){v1[2], v1[3]});
                        v0 = (f32x4){a.x, a.y, b.x, b.y}; v1 = (f32x4){c.x, c.y, d.x, d.y}; }
                    u32x4 w; w.x = cvt_pk_bf16(v0[0], v0[1]); w.y = cvt_pk_bf16(v0[2], v0[3]); w.z = cvt_pk_bf16(v1[0], v1[1]); w.w = cvt_pk_bf16(v1[2], v1[3]);
                    if (nt) __builtin_nontemporal_store(w, (u32x4*)(rowp + bj * HALF)); else *(u32x4*)(rowp + bj * HALF) = w; } }
    }
};

struct RmsStats {
    unsigned* xbuf;
    float eps;
    __device__ __forceinline__ void run(const f32x4 (&v)[2][2][4][2], const Unit& u, int wr, int wc, int fr, int fq, PG8_LAS unsigned char* lds, int wid, int lane) const {
        PG8_LAS float* P = (PG8_LAS float*)lds;
        PG8_LAS float* S = (PG8_LAS float*)(lds + 8192);
#pragma unroll
        for (int ai = 0; ai < 2; ++ai)
#pragma unroll
            for (int m = 0; m < 4; ++m) {
                float q = 0.f;
#pragma unroll
                for (int bj = 0; bj < 2; ++bj)
#pragma unroll
                    for (int n = 0; n < 2; ++n) { const f32x4 x = v[ai][bj][m][n]; q += (x[0] * x[0] + x[1] * x[1]) + (x[2] * x[2] + x[3] * x[3]); }
                q += __shfl_xor(q, 16); q += __shfl_xor(q, 32);
                if (fq == 0) P[(ai * HALF + wr * 64 + m * 16 + fr) * 4 + wc] = q;
            }
        asm volatile("s_waitcnt lgkmcnt(0)" ::: "memory"); __builtin_amdgcn_s_barrier(); asm volatile("" ::: "memory");
        if (lane < 32) {
            const int row = wid * 32 + lane;
            const float tot = (P[row * 4 + 0] + P[row * 4 + 1]) + (P[row * 4 + 2] + P[row * 4 + 3]);
            unsigned* slot = xbuf + (size_t)(u.pm * BM + row) * 4;
            __hip_atomic_store(slot + u.pn, __float_as_uint(tot) | 1u, __ATOMIC_RELAXED, __HIP_MEMORY_SCOPE_AGENT);
            unsigned a, b, c, d;
            for (unsigned spin = 0;; ++spin) {
                a = __hip_atomic_load(slot + 0, __ATOMIC_RELAXED, __HIP_MEMORY_SCOPE_AGENT); b = __hip_atomic_load(slot + 1, __ATOMIC_RELAXED, __HIP_MEMORY_SCOPE_AGENT);
                c = __hip_atomic_load(slot + 2, __ATOMIC_RELAXED, __HIP_MEMORY_SCOPE_AGENT); d = __hip_atomic_load(slot + 3, __ATOMIC_RELAXED, __HIP_MEMORY_SCOPE_AGENT);
                if ((a != 0u) & (b != 0u) & (c != 0u) & (d != 0u)) break;
                if (spin > (1u << 18)) break;
                __builtin_amdgcn_s_sleep(1);
            }
            const float q = (__uint_as_float(a) + __uint_as_float(b)) + (__uint_as_float(c) + __uint_as_float(d));
            S[row] = 1.0f / sqrtf(q * (1.0f / 1024.0f) + eps);
        }
        asm volatile("s_waitcnt vmcnt(0) lgkmcnt(0)" ::: "memory"); __builtin_amdgcn_s_barrier(); asm volatile("" ::: "memory");
    }
};

__device__ __forceinline__ f32x4 bf4(unsigned lo, unsigned hi) { return (f32x4){__uint_as_float(lo << 16), __uint_as_float(lo & 0xffff0000u), __uint_as_float(hi << 16), __uint_as_float(hi & 0xffff0000u)}; }
struct EpiRmsRes {
    static constexpr bool PERM = true, AFTER_DRAIN = true;
    const float* basef; const bf16_t* basebf; bf16_t* hs; const float* ga; float coef; float* ssout; RmsStats st;
    __device__ __forceinline__ void fused(f32x4 (&acc)[2][2][4][2], const Unit& u, int wr, int wc, int fr, int fq, PG8_LAS unsigned char* lds, int wid, int lane) const {
        PG8_LAS float* P = (PG8_LAS float*)lds;
        const PG8_LAS float* S = (const PG8_LAS float*)(lds + 8192);
        const int col0 = u.pn * BM + wc * 32 + 8 * fq;
        u32x4 pre[2][4][2]; f32x4 gv[2][2];
#pragma unroll
        for (int bj = 0; bj < 2; ++bj)
#pragma unroll
            for (int n = 0; n < 2; ++n) gv[bj][n] = *(const f32x4*)(ga + col0 + bj * HALF + n * 4);
        if (!basef) {
#pragma unroll
            for (int ai = 0; ai < 2; ++ai)
#pragma unroll
                for (int m = 0; m < 4; ++m) { const size_t off = (size_t)(u.pm * BM + ai * HALF + wr * 64 + m * 16 + fr) * 1024 + col0;
#pragma unroll
                    for (int bj = 0; bj < 2; ++bj) pre[ai][m][bj] = *(const u32x4*)(basebf + off + bj * HALF); } }
        st.run(acc, u, wr, wc, fr, fq, lds, wid, lane);
#pragma unroll
        for (int ai = 0; ai < 2; ++ai)
#pragma unroll
            for (int m = 0; m < 4; ++m) { const int r = ai * HALF + wr * 64 + m * 16 + fr; const float sr = S[r] * coef; const size_t off = (size_t)(u.pm * BM + r) * 1024 + col0; float q = 0.f;
#pragma unroll
                for (int bj = 0; bj < 2; ++bj) { f32x4 bs0, bs1;
                    if (basef) { bs0 = *(const f32x4*)(basef + off + bj * HALF); bs1 = *(const f32x4*)(basef + off + bj * HALF + 4); }
                    else { const u32x4 b4 = pre[ai][m][bj]; bs0 = bf4(b4.x, b4.y); bs1 = bf4(b4.z, b4.w); }
                    const f32x4 h0 = bs0 + acc[ai][bj][m][0] * sr * gv[bj][0], h1 = bs1 + acc[ai][bj][m][1] * sr * gv[bj][1];
                    q += ((h0[0] * h0[0] + h0[1] * h0[1]) + (h0[2] * h0[2] + h0[3] * h0[3])) + ((h1[0] * h1[0] + h1[1] * h1[1]) + (h1[2] * h1[2] + h1[3] * h1[3]));
                    u32x4 w; w.x = cvt_pk_bf16(h0[0], h0[1]); w.y = cvt_pk_bf16(h0[2], h0[3]); w.z = cvt_pk_bf16(h1[0], h1[1]); w.w = cvt_pk_bf16(h1[2], h1[3]);
                    *(u32x4*)(hs + off + bj * HALF) = w; }
                q += __shfl_xor(q, 16); q += __shfl_xor(q, 32);
                if (fq == 0) P[r * 4 + wc] = q;
                if (m & 1) asm volatile("" ::: "memory"); }
        asm volatile("s_waitcnt lgkmcnt(0)" ::: "memory"); __builtin_amdgcn_s_barrier(); asm volatile("" ::: "memory");
        if (lane < 32) { const int row = wid * 32 + lane; ssout[(size_t)(u.pm * BM + row) * 4 + u.pn] = (P[row * 4 + 0] + P[row * 4 + 1]) + (P[row * 4 + 2] + P[row * 4 + 3]); }
    }
};

struct EpiGateRms {
    static constexpr bool PERM = true, AFTER_DRAIN = true;
    const bf16_t* basebf; float* out; const bf16_t* E; const float* g; const float* ss; RmsStats st;
    __device__ __forceinline__ void fused(f32x4 (&acc)[2][2][4][2], const Unit& u, int wr, int wc, int fr, int fq, PG8_LAS unsigned char* lds, int wid, int lane) const {
        const PG8_LAS float* S = (const PG8_LAS float*)(lds + 8192);
        const int col0 = u.pn * BM + wc * 32 + 8 * fq;
        float rs[2][4]; row_scales(rs, ss, u, wr, fr);
#pragma unroll
        for (int ai = 0; ai < 2; ++ai)
#pragma unroll
            for (int m = 0; m < 4; ++m) { const int r = ai * HALF + wr * 64 + m * 16 + fr; const size_t off = (size_t)(u.pm * BM + r) * 1024 + col0;
#pragma unroll
                for (int bj = 0; bj < 2; ++bj) { const u32x4 e4 = *(const u32x4*)(E + off + bj * HALF);
                    const f32x4 ev0 = bf4(e4.x, e4.y), ev1 = bf4(e4.z, e4.w);
                    f32x4 a0 = acc[ai][bj][m][0] * rs[ai][m], a1 = acc[ai][bj][m][1] * rs[ai][m];
                    a0 = (f32x4){fast_sigmoid(a0[0]), fast_sigmoid(a0[1]), fast_sigmoid(a0[2]), fast_sigmoid(a0[3])};
                    a1 = (f32x4){fast_sigmoid(a1[0]), fast_sigmoid(a1[1]), fast_sigmoid(a1[2]), fast_sigmoid(a1[3])};
                    acc[ai][bj][m][0] = a0 * ev0; acc[ai][bj][m][1] = a1 * ev1; }
                asm volatile("" : "+v"(acc[ai][0][m][0]), "+v"(acc[ai][0][m][1]), "+v"(acc[ai][1][m][0]), "+v"(acc[ai][1][m][1]));
                if (m & 1) asm volatile("" ::: "memory"); }
        u32x4 pre[2][4][2]; f32x4 gv[2][2];
#pragma unroll
        for (int bj = 0; bj < 2; ++bj)
#pragma unroll
            for (int n = 0; n < 2; ++n) gv[bj][n] = *(const f32x4*)(g + col0 + bj * HALF + n * 4);
#pragma unroll
        for (int ai = 0; ai < 2; ++ai)
#pragma unroll
            for (int m = 0; m < 4; ++m) { const size_t off = (size_t)(u.pm * BM + ai * HALF + wr * 64 + m * 16 + fr) * 1024 + col0;
#pragma unroll
                for (int bj = 0; bj < 2; ++bj) pre[ai][m][bj] = *(const u32x4*)(basebf + off + bj * HALF); }
        st.run(acc, u, wr, wc, fr, fq, lds, wid, lane);
#pragma unroll
        for (int ai = 0; ai < 2; ++ai)
#pragma unroll
            for (int m = 0; m < 4; ++m) { const int r = ai * HALF + wr * 64 + m * 16 + fr; const float sr = S[r]; const size_t off = (size_t)(u.pm * BM + r) * 1024 + col0;
#pragma unroll
                for (int bj = 0; bj < 2; ++bj) { const u32x4 b4 = pre[ai][m][bj]; const f32x4 bs0 = bf4(b4.x, b4.y), bs1 = bf4(b4.z, b4.w);
                    *(f32x4*)(out + off + bj * HALF) = bs0 + acc[ai][bj][m][0] * sr * gv[bj][0];
                    *(f32x4*)(out + off + bj * HALF + 4) = bs1 + acc[ai][bj][m][1] * sr * gv[bj][1]; }
                if (m & 1) asm volatile("" ::: "memory"); }
    }
};

template <class Epi, class Sched, bool ALIGN_EPI = false, bool SP2 = false>
__device__ __forceinline__ void gemm_phase(PG8_LAS unsigned char* lds, const Gemm g, const Sched& S, const Epi& E) {
    int tid_ = threadIdx.x; asm volatile("" : "+v"(tid_));
    const int tid = tid_, wid = __builtin_amdgcn_readfirstlane(tid >> 6), lane = tid & 63, wr = wid >> 2, wc = wid & 3, fr = lane & 15, fq = lane >> 4;
    const int K = g.K, nt = K / BK, lda = g.lda ? g.lda : K;
    unsigned voffA[2], voffB[2];
#pragma unroll
    for (int i = 0; i < 2; ++i) { int R, C; stage_rc(tid * 16 + i * 8192, R, C); const int Rb = Epi::PERM ? ((R & ~31) + perm32(R & 31)) : R;
        voffA[i] = (unsigned)(R * lda + C) * 2u; voffB[i] = (unsigned)(Rb * K + C) * 2u; }
    const size_t kstep = (size_t)(BK * 2);
    const size_t hstep = (size_t)HALF * K * 2;
    const size_t tstep = 2 * hstep;
    const size_t hstepA = (size_t)HALF * lda * 2, tstepA = 2 * hstepA;
    const unsigned ldsw = (unsigned)wid * 1024u;
    const int aoff = lds_byte(wr * 64 + fr, fq * 8), boff = lds_byte(wc * 32 + fr, fq * 8);
#define PG8_SA(b, h) (((b) * 2 + (h)) * HTB)
#define PG8_SB(b, h) ((4 + (b) * 2 + (h)) * HTB)
#define PG8_STAGE(bufoff, gbase, voff) do { _Pragma("unroll") for (int _i = 0; _i < 2; ++_i) \
        __builtin_amdgcn_global_load_lds((const unsigned*)((const char*)(gbase) + (voff)[_i]), (PG8_LAS unsigned*)(lds + (bufoff) + ldsw + _i * 8192), 16, 0, 0); } while (0)
#define PG8_LDA(dst, b, h) do { _Pragma("unroll") for (int m = 0; m < 4; ++m) _Pragma("unroll") for (int k = 0; k < 2; ++k) dst[m][k] = *(const PG8_LAS bf16x8*)(lds + PG8_SA(b, h) + aoff + m * 2048 + k * 1024); } while (0)
#define PG8_LDB(dst, b, h) do { _Pragma("unroll") for (int n = 0; n < 2; ++n) _Pragma("unroll") for (int k = 0; k < 2; ++k) dst[n][k] = *(const PG8_LAS bf16x8*)(lds + PG8_SB(b, h) + boff + n * 2048 + k * 1024); } while (0)
#define PG8_MMA(ai, bj, At, Bt) do { __builtin_amdgcn_s_setprio(1); _Pragma("unroll") for (int m = 0; m < 4; ++m) _Pragma("unroll") for (int n = 0; n < 2; ++n) _Pragma("unroll") for (int k = 0; k < 2; ++k) \
        acc[ai][bj][m][n] = __builtin_amdgcn_mfma_f32_16x16x32_bf16(Bt[n][k], At[m][k], acc[ai][bj][m][n], 0, 0, 0); __builtin_amdgcn_s_setprio(0); } while (0)
#define PG8_WAIT_V(n) asm volatile("s_waitcnt vmcnt(" #n ")" ::: "memory")
#define PG8_WAIT_L(n) asm volatile("s_waitcnt lgkmcnt(" #n ")" ::: "memory")
#define PG8_BAR __builtin_amdgcn_s_barrier()
#define PG8_SCHED __builtin_amdgcn_sched_barrier(0)
    Unit cur, nxt; int ui = 0;
    if (!S.next(0, cur)) return;
    f32x4 acc[2][2][4][2];
#pragma unroll
    for (int a = 0; a < 2; ++a)
#pragma unroll
        for (int b = 0; b < 2; ++b)
#pragma unroll
            for (int m = 0; m < 4; ++m)
#pragma unroll
                for (int n = 0; n < 2; ++n) acc[a][b][m][n] = (f32x4){0.f, 0.f, 0.f, 0.f};
    bf16x8 At[4][2], B0[2][2], B1[2][2];
    const char* cA = (const char*)g.A + (size_t)cur.pm * tstepA; const char* cB = (const char*)g.Bt + (size_t)cur.pn * tstep;
    S.a_ready(cur);
    if constexpr (SP2) {
        PG8_STAGE(PG8_SB(0, 0), cB, voffB); PG8_STAGE(PG8_SB(0, 1), cB + hstep, voffB); PG8_STAGE(PG8_SA(0, 0), cA, voffA); PG8_STAGE(PG8_SA(0, 1), cA + hstepA, voffA);
        if (wr == 1) PG8_BAR;
        PG8_WAIT_V(2); PG8_BAR;
        PG8_STAGE(PG8_SB(1, 0), cB + kstep, voffB); PG8_STAGE(PG8_SA(1, 0), cA + kstep, voffA); PG8_STAGE(PG8_SB(1, 1), cB + hstep + kstep, voffB);
        PG8_WAIT_V(6); PG8_BAR;
    } else {
        PG8_STAGE(PG8_SB(0, 0), cB, voffB); PG8_STAGE(PG8_SA(0, 0), cA, voffA); PG8_STAGE(PG8_SB(0, 1), cB + hstep, voffB); PG8_STAGE(PG8_SA(0, 1), cA + hstepA, voffA);
        if (wr == 1) PG8_BAR;
        PG8_WAIT_V(4); PG8_BAR;
        PG8_STAGE(PG8_SB(1, 0), cB + kstep, voffB); PG8_STAGE(PG8_SA(1, 0), cA + kstep, voffA); PG8_STAGE(PG8_SB(1, 1), cB + hstep + kstep, voffB);
        PG8_WAIT_V(6); PG8_BAR;
    }
    for (;;) {
        const bool has_next = S.next(ui + 1, nxt);
        const char* nA = has_next ? (const char*)g.A + (size_t)nxt.pm * tstepA : cA; const char* nB = has_next ? (const char*)g.Bt + (size_t)nxt.pn * tstep : cB;
        for (int t = 0; t < nt; t += 2) {
            const bool last = (t == nt - 2);
            const char* a1 = cA + (size_t)(t + 1) * kstep;
            const char* a2 = last ? nA : cA + (size_t)(t + 2) * kstep; const char* b2 = last ? nB : cB + (size_t)(t + 2) * kstep;
            const char* a3 = a2 + kstep; const char* b3 = b2 + kstep;
            if (last && has_next) S.a_ready(nxt);
            if constexpr (SP2) {
            PG8_LDB(B0, 0, 0); PG8_LDB(B1, 0, 1); PG8_SCHED; PG8_LDA(At, 0, 0); PG8_STAGE(PG8_SA(1, 1), a1 + hstepA, voffA);
            PG8_WAIT_V(8); PG8_WAIT_L(0); PG8_BAR; PG8_MMA(0, 0, At, B0); PG8_MMA(0, 1, At, B1); PG8_BAR; PG8_SCHED;
            PG8_LDA(At, 0, 1); PG8_STAGE(PG8_SB(0, 0), b2, voffB); PG8_STAGE(PG8_SB(0, 1), b2 + hstep, voffB); PG8_STAGE(PG8_SA(0, 0), a2, voffA);
            PG8_WAIT_V(8); PG8_WAIT_L(0); PG8_BAR; PG8_MMA(1, 0, At, B0); PG8_MMA(1, 1, At, B1); PG8_BAR; PG8_SCHED;
            PG8_LDB(B0, 1, 0); PG8_LDB(B1, 1, 1); PG8_SCHED; PG8_LDA(At, 1, 0); PG8_STAGE(PG8_SA(0, 1), a2 + hstepA, voffA);
            PG8_WAIT_V(8); PG8_WAIT_L(0); PG8_BAR; PG8_MMA(0, 0, At, B0); PG8_MMA(0, 1, At, B1); PG8_BAR; PG8_SCHED;
            PG8_LDA(At, 1, 1); PG8_STAGE(PG8_SB(1, 0), b3, voffB); PG8_STAGE(PG8_SB(1, 1), b3 + hstep, voffB); PG8_STAGE(PG8_SA(1, 0), a3, voffA);
            PG8_WAIT_V(8); PG8_WAIT_L(0); PG8_BAR; PG8_MMA(1, 0, At, B0); PG8_MMA(1, 1, At, B1); PG8_BAR; PG8_SCHED;
            } else {
            PG8_LDB(B0, 0, 0); PG8_SCHED; PG8_LDA(At, 0, 0); PG8_STAGE(PG8_SA(1, 1), a1 + hstepA, voffA);
            PG8_WAIT_L(8); PG8_BAR; PG8_WAIT_L(0); PG8_MMA(0, 0, At, B0); PG8_BAR; PG8_SCHED;
            PG8_LDB(B1, 0, 1); PG8_STAGE(PG8_SB(0, 0), b2, voffB);
            PG8_BAR; PG8_WAIT_L(0); PG8_MMA(0, 1, At, B1); PG8_BAR;
            PG8_LDA(At, 0, 1); PG8_STAGE(PG8_SA(0, 0), a2, voffA);
            PG8_BAR; PG8_WAIT_L(0); PG8_MMA(1, 0, At, B0); PG8_BAR; PG8_SCHED;
            PG8_STAGE(PG8_SB(0, 1), b2 + hstep, voffB);
            PG8_WAIT_V(6); PG8_BAR; PG8_MMA(1, 1, At, B1); PG8_BAR;
            PG8_LDB(B0, 1, 0); PG8_SCHED; PG8_LDA(At, 1, 0); PG8_STAGE(PG8_SA(0, 1), a2 + hstepA, voffA);
            PG8_WAIT_L(8); PG8_BAR; PG8_WAIT_L(0); PG8_MMA(0, 0, At, B0); PG8_BAR; PG8_SCHED;
            PG8_LDB(B1, 1, 1); PG8_STAGE(PG8_SB(1, 0), b3, voffB);
            PG8_BAR; PG8_WAIT_L(0); PG8_MMA(0, 1, At, B1); PG8_BAR;
            PG8_LDA(At, 1, 1); PG8_STAGE(PG8_SA(1, 0), a3, voffA);
            PG8_BAR; PG8_WAIT_L(0); PG8_MMA(1, 0, At, B0); PG8_BAR; PG8_SCHED;
            PG8_STAGE(PG8_SB(1, 1), b3 + hstep, voffB);
            PG8_WAIT_V(6); PG8_BAR; PG8_MMA(1, 1, At, B1); PG8_BAR;
            }
        }
        if constexpr (ALIGN_EPI) { if (wr == 0) PG8_BAR; }
        if constexpr (!Epi::AFTER_DRAIN) { E(acc, cur, wr, wc, fr, fq); S.done(cur); }
        if (!has_next) break;
#pragma unroll
        for (int a = 0; a < 2; ++a)
#pragma unroll
            for (int b = 0; b < 2; ++b)
#pragma unroll
                for (int m = 0; m < 4; ++m)
#pragma unroll
                    for (int n = 0; n < 2; ++n) acc[a][b][m][n] = (f32x4){0.f, 0.f, 0.f, 0.f};
        cur = nxt; cA = nA; cB = nB; ++ui;
        if constexpr (ALIGN_EPI) { if (wr == 1) PG8_BAR; }
    }
    PG8_WAIT_V(0);
    if constexpr (!ALIGN_EPI) { if (wr == 0) PG8_BAR; }
    PG8_BAR;
    if constexpr (Epi::AFTER_DRAIN) { E.fused(acc, cur, wr, wc, fr, fq, lds, wid, lane); S.done(cur); }
#undef PG8_SA
#undef PG8_SB
#undef PG8_STAGE
#undef PG8_LDA
#undef PG8_LDB
#undef PG8_MMA
#undef PG8_WAIT_V
#undef PG8_WAIT_L
#undef PG8_BAR
#undef PG8_SCHED
}
}


#define LAS __attribute__((address_space(3)))
typedef unsigned short bf16;
typedef unsigned v4u __attribute__((ext_vector_type(4)));
typedef unsigned v2u __attribute__((ext_vector_type(2)));
typedef float f32x4 __attribute__((ext_vector_type(4)));
typedef float f32x2 __attribute__((ext_vector_type(2)));
typedef short bf16x8 __attribute__((ext_vector_type(8)));

constexpr int NWAVES = 8, NTHR = 512;
constexpr int BATCH = 8, SEQ = 2048, D = 1024, M = BATCH * SEQ, DPLE = 256, DFF = 2816, NGU = 2 * DFF, INC = 3080, NPROJ = 3072, NCH = 16, CH = 128;
constexpr float EPS = 1e-6f;
constexpr int LDS_BYTES = 151552;

constexpr size_t MiB = 1u << 20;
constexpr size_t WS_CTL = 234 * MiB - 131072, WS_ZERO = WS_CTL, ZERO_BYTES = 131072 + 1 * MiB;
constexpr size_t WS_WGU1 = 1 * MiB;
constexpr size_t WS_WD1 = WS_WGU1 + (size_t)NGU * D * 2;
constexpr size_t WS_WGU2 = WS_WD1 + (size_t)D * DFF * 2;
constexpr size_t WS_WD2 = WS_WGU2 + (size_t)NGU * D * 2;
constexpr size_t WS_WIN = WS_WD2 + (size_t)D * DFF * 2;
constexpr size_t WS_WOUT = WS_WIN + (size_t)NPROJ * D * 2;
constexpr size_t WS_WPLE = WS_WOUT + (size_t)D * D * 2;
constexpr size_t WS_WGATE = WS_WPLE + (size_t)D * DPLE * 2;
constexpr size_t WS_WEND = WS_WGATE + (size_t)D * D * 2;
static_assert(WS_WEND <= 48 * MiB, "weights");
constexpr size_t WS_XN = 48 * MiB;
constexpr size_t WS_HS = WS_XN;
constexpr size_t WS_CTLOC = 240 * MiB;
constexpr size_t WS_H = 80 * MiB;
constexpr size_t WS_PROJ = WS_H;
constexpr size_t WS_MIX = 176 * MiB;
constexpr size_t WS_E = WS_MIX;
constexpr size_t WS_PB = 208 * MiB;
constexpr size_t WS_CTIN = 216 * MiB;
constexpr size_t WS_GATES = 232 * MiB;
constexpr size_t WS_SMALL = 233 * MiB;
constexpr size_t WS_WSPB = 233 * MiB + 640 * 1024;
constexpr size_t WS_WGT = 233 * MiB + 768 * 1024;
constexpr size_t WS_XCH = 234 * MiB;
constexpr size_t WS_END = 256 * MiB;
constexpr int CW_BAR = 0, MISC_OFF = 151040;

__device__ __forceinline__ unsigned f2bf(float f) { unsigned u = __builtin_bit_cast(unsigned, f); return (u + 0x7fffu + ((u >> 16) & 1u)) >> 16; }
typedef __bf16 bf16x2_t __attribute__((ext_vector_type(2)));
__device__ __forceinline__ unsigned pk2(float lo, float hi) { const f32x2 v = {lo, hi}; return __builtin_bit_cast(unsigned, __builtin_convertvector(v, bf16x2_t)); }
__device__ __forceinline__ float bflo(unsigned w) { return __uint_as_float(w << 16); }
__device__ __forceinline__ float bfhi(unsigned w) { return __uint_as_float(w & 0xffff0000u); }
#define LDS_WAIT() asm volatile("s_waitcnt lgkmcnt(0)" ::: "memory")
__device__ __forceinline__ float wave_sum(float v) {
#pragma unroll
    for (int o = 1; o < 64; o <<= 1) v += __shfl_xor(v, o);
    return v;
}
__device__ __forceinline__ float wave_max(float v) {
#pragma unroll
    for (int o = 1; o < 64; o <<= 1) v = fmaxf(v, __shfl_xor(v, o));
    return v;
}
template <int CTRL, int RM> __device__ __forceinline__ float dpp_f(float identity, float v) { return __int_as_float(__builtin_amdgcn_update_dpp(__float_as_int(identity), __float_as_int(v), CTRL, RM, 0xf, false)); }
__device__ __forceinline__ float wscan_add(float v, int) {
    v += dpp_f<0x111, 0xf>(0.f, v); v += dpp_f<0x112, 0xf>(0.f, v); v += dpp_f<0x114, 0xf>(0.f, v); v += dpp_f<0x118, 0xf>(0.f, v);
    v += dpp_f<0x142, 0xa>(0.f, v); v += dpp_f<0x143, 0xc>(0.f, v); return v;
}
__device__ __forceinline__ float wscan_max(float v, int) {
    const float ninf = -__builtin_inff();
    v = fmaxf(v, dpp_f<0x111, 0xf>(ninf, v)); v = fmaxf(v, dpp_f<0x112, 0xf>(ninf, v)); v = fmaxf(v, dpp_f<0x114, 0xf>(ninf, v)); v = fmaxf(v, dpp_f<0x118, 0xf>(ninf, v));
    v = fmaxf(v, dpp_f<0x142, 0xa>(ninf, v)); v = fmaxf(v, dpp_f<0x143, 0xc>(ninf, v)); return v;
}

#define XB_TMO      128
#define XB_XCNT(j)  (256  + 64 * (j))
#define XB_XSUB(j)  (1280 + 64 * (j))
#define XB_XGEN(j)  (2304 + 64 * (j))
#define XB_TOP      3328
#define XB_TOPGEN   3392
#define XCD_BAR_WORDS 3456
#define XB_SPIN_CAP (1u << 18)
__device__ __forceinline__ unsigned xb_ld(unsigned* p)              { return __hip_atomic_load(p, __ATOMIC_RELAXED, __HIP_MEMORY_SCOPE_AGENT); }
__device__ __forceinline__ unsigned xb_add(unsigned* p, unsigned v) { return __hip_atomic_fetch_add(p, v, __ATOMIC_RELAXED, __HIP_MEMORY_SCOPE_AGENT); }
__device__ __forceinline__ unsigned xb_xcc_id() { return (unsigned)__builtin_amdgcn_s_getreg((3 << 11) | 20) & 0xFu; }
#define XB_SPIN(cond, bar) do { unsigned _sp = 0; while (cond) { __builtin_amdgcn_s_sleep(1); \
    if ((++_sp & 255u) == 0u) { if (xb_ld(&(bar)[XB_TMO])) break; if (_sp > XB_SPIN_CAP) { atomicAdd(&(bar)[XB_TMO], 1u); break; } } } } while (0)
struct XcdBarrier { unsigned* bar; unsigned x; volatile LAS unsigned* st; };
__device__ __forceinline__ XcdBarrier xcd_barrier_post(unsigned* bar, volatile LAS unsigned* st) {
    XcdBarrier b; b.bar = bar; b.x = xb_xcc_id(); b.st = st;
    if (threadIdx.x == 0) (void)xb_add(&bar[XB_XCNT(b.x)], 1u);
    return b;
}
__device__ __forceinline__ void xcd_barrier_complete(unsigned* bar, unsigned x, unsigned& nloc, unsigned& nx) {
    const unsigned G = gridDim.x * gridDim.y * gridDim.z;
    unsigned sum, cnt, mine, sp = 0u;
    for (;;) {
        sum = 0u; cnt = 0u; mine = 0u;
#pragma unroll
        for (unsigned j = 0; j < 16; ++j) { const unsigned c = xb_ld(&bar[XB_XCNT(j)]); sum += c; cnt += (c > 0u) ? 1u : 0u; mine = (j == x) ? c : mine; }
        if (sum == G) break;
        __builtin_amdgcn_s_sleep(1);
        if ((++sp & 255u) == 0u) { if (xb_ld(&bar[XB_TMO])) break; if (sp > XB_SPIN_CAP) { atomicAdd(&bar[XB_TMO], 1u); break; } }
    }
    nloc = mine > 0u ? mine : 1u; nx = cnt > 0u ? cnt : 1u;
}
__device__ __forceinline__ void xcd_barrier(const XcdBarrier& b) {
    asm volatile("s_waitcnt vmcnt(0)" ::: "memory");
    __syncthreads();
    if (threadIdx.x == 0) {
        unsigned* bar = b.bar;
        __builtin_amdgcn_s_waitcnt(0);
        unsigned nloc = b.st[0], nx = b.st[1];
        if (nloc == 0u) { xcd_barrier_complete(bar, b.x, nloc, nx); b.st[0] = nloc; b.st[1] = nx; }
        const unsigned old = xb_add(&bar[XB_XSUB(b.x)], 1u);
        const unsigned gen = old / nloc;
        if (old + 1u == (gen + 1u) * nloc) {
            __builtin_amdgcn_fence(__ATOMIC_RELEASE, "agent");
            asm volatile("s_waitcnt vmcnt(0)" ::: "memory");
            (void)xb_add(&bar[XB_TOP], 1u);
        }
        const unsigned want = (gen + 1u) * nx;
        XB_SPIN(xb_ld(&bar[XB_TOP]) < want, bar);
        __builtin_amdgcn_fence(__ATOMIC_ACQUIRE, "agent");
        asm volatile("s_waitcnt vmcnt(0)" ::: "memory");
    }
    __syncthreads();
}

#define GB_XCNT(g, j) ((g) * 2048 + 64 * (j))
#define GB_XSUB(g, j) ((g) * 2048 + 1024 + 64 * (j))
#define GB_TOP(g)     (8 * 2048 + 64 * (g))
#define GB_WORDS      (8 * 2048 + 512)
struct GrpBarrier { unsigned* base; unsigned* tmo; unsigned g, x, gsize; volatile LAS unsigned* st; };
__device__ __forceinline__ GrpBarrier grp_barrier_post(unsigned* base, unsigned* tmo, volatile LAS unsigned* st) {
    GrpBarrier b; b.base = base; b.tmo = tmo; b.g = blockIdx.x & 7u; b.x = xb_xcc_id(); b.st = st; b.gsize = (gridDim.x - b.g + 7u) / 8u;
    if (threadIdx.x == 0) (void)xb_add(&base[GB_XCNT(b.g, b.x)], 1u);
    return b;
}
__device__ __forceinline__ void grp_barrier(const GrpBarrier& b) {
    asm volatile("s_waitcnt vmcnt(0)" ::: "memory");
    __syncthreads();
    if (threadIdx.x == 0) {
        unsigned* base = b.base; unsigned* bar = b.tmo;
        __builtin_amdgcn_s_waitcnt(0);
        unsigned nloc = b.st[0], nx = b.st[1];
        if (nloc == 0u) {
            unsigned sum, cnt, mine, sp = 0u;
            for (;;) { sum = 0u; cnt = 0u; mine = 0u;
#pragma unroll
                for (unsigned j = 0; j < 16; ++j) { const unsigned c = xb_ld(&base[GB_XCNT(b.g, j)]); sum += c; cnt += (c > 0u) ? 1u : 0u; mine = (j == b.x) ? c : mine; }
                if (sum == b.gsize) break;
                __builtin_amdgcn_s_sleep(1);
                if ((++sp & 255u) == 0u) { if (xb_ld(&bar[XB_TMO])) break; if (sp > XB_SPIN_CAP) { atomicAdd(&bar[XB_TMO], 1u); break; } } }
            nloc = mine > 0u ? mine : 1u; nx = cnt > 0u ? cnt : 1u; b.st[0] = nloc; b.st[1] = nx; }
        const unsigned old = xb_add(&base[GB_XSUB(b.g, b.x)], 1u);
        const unsigned gen = old / nloc;
        if (old + 1u == (gen + 1u) * nloc) {
            __builtin_amdgcn_fence(__ATOMIC_RELEASE, "agent");
            asm volatile("s_waitcnt vmcnt(0)" ::: "memory");
            (void)xb_add(&base[GB_TOP(b.g)], 1u);
        }
        const unsigned want = (gen + 1u) * nx;
        XB_SPIN(xb_ld(&base[GB_TOP(b.g)]) < want, bar);
        __builtin_amdgcn_fence(__ATOMIC_ACQUIRE, "agent");
        asm volatile("s_waitcnt vmcnt(0)" ::: "memory");
    }
    __syncthreads();
}

struct Params { const float* in[19]; float* out; unsigned char* ws; };

__device__ __forceinline__ void tr_item(const float* W, int ldw, int K, bf16* WT, int src_col0, int dst_row0, int k0, LAS float* scr, int lane, const float* gk) {
    float wv[32];
#pragma unroll
    for (int i = 0; i < 32; ++i) { const int kk = 2 * i + (lane >> 5); wv[i] = W[(size_t)(k0 + kk) * ldw + src_col0 + (lane & 31)]; }
    if (gk) {
#pragma unroll
        for (int i = 0; i < 32; ++i) wv[i] *= gk[k0 + 2 * i + (lane >> 5)]; }
#pragma unroll
    for (int i = 0; i < 32; ++i) { const int kk = 2 * i + (lane >> 5); scr[kk * 33 + (lane & 31)] = wv[i]; }
    LDS_WAIT(); asm volatile("" ::: "memory");
    const int c = lane & 7;
#pragma unroll
    for (int j = 0; j < 4; ++j) { const int n = (lane >> 3) + 8 * j; const LAS float* s = scr + (8 * c) * 33 + n;
        v4u o; o.x = pk2(s[0 * 33], s[1 * 33]); o.y = pk2(s[2 * 33], s[3 * 33]); o.z = pk2(s[4 * 33], s[5 * 33]); o.w = pk2(s[6 * 33], s[7 * 33]);
        *(v4u*)(WT + (size_t)(dst_row0 + n) * K + k0 + 8 * c) = o; }
    LDS_WAIT(); asm volatile("" ::: "memory");
}
__device__ __forceinline__ void tr_matrix_item(const float* W, int ldw, int K, int Ndst, bf16* WT, int mode, int item, LAS float* scr, int lane, const float* gk = nullptr) {
    const int nblk = Ndst / 32, kb = item / nblk, nb = item % nblk, d0 = nb * 32;
    int s0 = d0;
    if (mode == 1) { const int pn = d0 >> 8, bj = (d0 >> 7) & 1, c = d0 & 127; s0 = bj * DFF + 128 * pn + c; }
    else if (mode == 2) { s0 = d0 < 2048 ? d0 : d0 + 8; }
    tr_item(W, ldw, K, WT, s0, d0, kb * 64, scr, lane, gk);
}
__device__ __forceinline__ void x_row2_to_bf16(const float* xa, const float* xb, bf16* oa, bf16* ob, float* ssa, float* ssb, int lane) {
    const f32x4* ra = (const f32x4*)xa + lane; const f32x4* rb = (const f32x4*)xb + lane;
    f32x4 va[4], vb[4]; float sa = 0.f, sb = 0.f;
#pragma unroll
    for (int j = 0; j < 4; ++j) { va[j] = ra[64 * j]; vb[j] = rb[64 * j]; }
#pragma unroll
    for (int j = 0; j < 4; ++j) { sa += (va[j].x * va[j].x + va[j].y * va[j].y) + (va[j].z * va[j].z + va[j].w * va[j].w); sb += (vb[j].x * vb[j].x + vb[j].y * vb[j].y) + (vb[j].z * vb[j].z + vb[j].w * vb[j].w); }
    sa = wave_sum(sa); sb = wave_sum(sb);
    unsigned long long* o8a = (unsigned long long*)oa + lane; unsigned long long* o8b = (unsigned long long*)ob + lane;
#pragma unroll
    for (int j = 0; j < 4; ++j) {
        o8a[64 * j] = (unsigned long long)pk2(va[j].x, va[j].y) | ((unsigned long long)pk2(va[j].z, va[j].w) << 32);
        o8b[64 * j] = (unsigned long long)pk2(vb[j].x, vb[j].y) | ((unsigned long long)pk2(vb[j].z, vb[j].w) << 32); }
    if (lane == 0) { *(f32x4*)ssa = (f32x4){sa, 0.f, 0.f, 0.f}; *(f32x4*)ssb = (f32x4){sb, 0.f, 0.f, 0.f}; }
}
constexpr int LROW = 272;
constexpr int BUF_BYTES = 128 * LROW;
constexpr int SM_OFF = 4 * BUF_BYTES;
__device__ __forceinline__ void lds_mma(f32x4 (&acc)[2][4], const LAS unsigned char* X, const LAS unsigned char* Y, int wr2, int wc2, int fr, int fq) {
#pragma unroll
    for (int ks = 0; ks < 4; ++ks) {
        bf16x8 xa[2], yb[4];
#pragma unroll
        for (int m = 0; m < 2; ++m) xa[m] = *(const LAS bf16x8*)(X + (32 * wr2 + 16 * m + fr) * LROW + ks * 64 + fq * 16);
#pragma unroll
        for (int n = 0; n < 4; ++n) yb[n] = *(const LAS bf16x8*)(Y + (64 * wc2 + 16 * n + fr) * LROW + ks * 64 + fq * 16);
#pragma unroll
        for (int m = 0; m < 2; ++m)
#pragma unroll
            for (int n = 0; n < 4; ++n) acc[m][n] = __builtin_amdgcn_mfma_f32_16x16x32_bf16(yb[n], xa[m], acc[m][n], 0, 0, 0);
    }
}
__device__ __forceinline__ void lds_mma16(f32x4 (&acc)[8], const LAS unsigned char* X, const LAS unsigned char* Y, int xrow0, int fr, int fq) {
#pragma unroll
    for (int ks = 0; ks < 4; ++ks) {
        const bf16x8 xa = *(const LAS bf16x8*)(X + (xrow0 + fr) * LROW + ks * 64 + fq * 16);
        bf16x8 yb[8];
#pragma unroll
        for (int n = 0; n < 8; ++n) yb[n] = *(const LAS bf16x8*)(Y + (16 * n + fr) * LROW + ks * 64 + fq * 16);
#pragma unroll
        for (int n = 0; n < 8; ++n) acc[n] = __builtin_amdgcn_mfma_f32_16x16x32_bf16(yb[n], xa, acc[n], 0, 0, 0);
    }
}
__device__ __forceinline__ void zero_acc8(f32x4 (&acc)[8]) {
#pragma unroll
    for (int n = 0; n < 8; ++n) acc[n] = (f32x4){0.f, 0.f, 0.f, 0.f};
}
__device__ __forceinline__ void zero_acc(f32x4 (&acc)[2][4]) {
#pragma unroll
    for (int m = 0; m < 2; ++m)
#pragma unroll
        for (int n = 0; n < 4; ++n) acc[m][n] = (f32x4){0.f, 0.f, 0.f, 0.f};
}
__device__ __forceinline__ float bfel(const v4u& w, int e) { const unsigned x = (e >> 1) == 0 ? w.x : (e >> 1) == 1 ? w.y : (e >> 1) == 2 ? w.z : w.w; return (e & 1) ? bfhi(x) : bflo(x); }

__device__ __forceinline__ void conv_load(const bf16* PROJ, int row0, int ch0, int rg, v4u (&raw)[7]) {
#pragma unroll
    for (int i = 0; i < 7; ++i) { int rr = row0 + 4 * rg - 3 + i; rr = rr < 0 ? 0 : rr; raw[i] = *(const v4u*)(PROJ + (size_t)rr * NPROJ + ch0); }
}
struct ConvW { f32x4 w0[4], w1[4], b0, b1; };
__device__ __forceinline__ void conv_wload(ConvW& W, const float* conv_w, const float* conv_b, int ch0) {
    W.b0 = *(const f32x4*)(conv_b + ch0); W.b1 = *(const f32x4*)(conv_b + ch0 + 4);
#pragma unroll
    for (int j = 0; j < 4; ++j) { W.w0[j] = *(const f32x4*)(conv_w + j * 1024 + ch0); W.w1[j] = *(const f32x4*)(conv_w + j * 1024 + ch0 + 4); }
}
__device__ __forceinline__ void conv_compute(v4u (&raw)[7], const ConvW& W, bool first_chunk, int rg, float (&y)[4][8]) {
#pragma unroll
    for (int i = 0; i < 3; ++i) { const bool z = first_chunk && (4 * rg - 3 + i < 0); raw[i].x = z ? 0u : raw[i].x; raw[i].y = z ? 0u : raw[i].y; raw[i].z = z ? 0u : raw[i].z; raw[i].w = z ? 0u : raw[i].w; }
    const f32x4 b0 = W.b0, b1 = W.b1;
#pragma unroll
    for (int rr = 0; rr < 4; ++rr)
#pragma unroll
        for (int e = 0; e < 8; ++e) y[rr][e] = e < 4 ? b0[e & 3] : b1[e & 3];
#pragma unroll
    for (int j = 0; j < 4; ++j) { const f32x4 w0 = W.w0[j], w1 = W.w1[j];
#pragma unroll
        for (int rr = 0; rr < 4; ++rr)
#pragma unroll
            for (int e = 0; e < 8; ++e) y[rr][e] += (e < 4 ? w0[e & 3] : w1[e & 3]) * bfel(raw[rr + j], e); }
#pragma unroll
    for (int rr = 0; rr < 4; ++rr)
#pragma unroll
        for (int e = 0; e < 8; ++e) { const float v = y[rr][e]; y[rr][e] = v * __builtin_amdgcn_rcpf(1.0f + __expf(-v)); }
}
__device__ __forceinline__ void put_natural(LAS unsigned char* buf, int rg, int oct, const float (&y)[4][8], float scale) {
#pragma unroll
    for (int rr = 0; rr < 4; ++rr) { v4u w; w.x = pk2(y[rr][0] * scale, y[rr][1] * scale); w.y = pk2(y[rr][2] * scale, y[rr][3] * scale); w.z = pk2(y[rr][4] * scale, y[rr][5] * scale); w.w = pk2(y[rr][6] * scale, y[rr][7] * scale);
        *(LAS v4u*)(buf + (4 * rg + rr) * LROW + oct * 16) = w; }
}
__device__ __forceinline__ int ypos(int e) { return (e & ~31) | ((e & 4) << 2) | ((e >> 1) & 12) | (e & 3); }
template <bool PERMY = false> __device__ __forceinline__ void put_transposed(LAS unsigned char* buf, int rg, int oct, const float (&y)[4][8], const float (&rs)[4]) {
#pragma unroll
    for (int e = 0; e < 8; ++e) { v2u w; w.x = pk2(y[0][e] * rs[0], y[1][e] * rs[1]); w.y = pk2(y[2][e] * rs[2], y[3][e] * rs[3]);
        *(LAS v2u*)(buf + (PERMY ? ypos(oct * 8 + e) : oct * 8 + e) * LROW + rg * 8) = w; }
}
__device__ __forceinline__ void v_load(const bf16* PROJ, int row0, int c0, int rg, v4u (&raw)[4]) {
#pragma unroll
    for (int rr = 0; rr < 4; ++rr) raw[rr] = *(const v4u*)(PROJ + (size_t)(row0 + 4 * rg + rr) * NPROJ + c0);
}
template <bool PERMY = false> __device__ __forceinline__ void v_put_transposed(const v4u (&raw)[4], int rg, int oct, LAS unsigned char* buf) {
#pragma unroll
    for (int e = 0; e < 8; ++e) {
        unsigned x[4];
#pragma unroll
        for (int rr = 0; rr < 4; ++rr) { const unsigned w = (e >> 1) == 0 ? raw[rr].x : (e >> 1) == 1 ? raw[rr].y : (e >> 1) == 2 ? raw[rr].z : raw[rr].w; x[rr] = (e & 1) ? (w >> 16) : (w & 0xffffu); }
        v2u o; o.x = x[0] | (x[1] << 16); o.y = x[2] | (x[3] << 16);
        *(LAS v2u*)(buf + (PERMY ? ypos(oct * 8 + e) : oct * 8 + e) * LROW + rg * 8) = o; }
}

__device__ __forceinline__ void pf_ld(unsigned& d, const unsigned char* a) { asm volatile("global_load_dword %0, %1, off" : "=v"(d) : "v"(a) : "memory"); }
__device__ __forceinline__ void pf_issue(const Params& p, int kind, int unit, int tid, unsigned (&pf)[3]) {
    pf[0] = 0u; pf[1] = 0u; pf[2] = 0u;
    if (unit < 0) return;
    const unsigned char* PROJb = p.ws + WS_PROJ; const int row = tid >> 2, sel = tid & 3;
    if (kind == 1) { const int b = unit >> 5, c = (unit >> 1) & 15, pr = unit & 1; const unsigned char* r = PROJb + (size_t)(b * SEQ + c * CH + row) * (NPROJ * 2);
        pf_ld(pf[0], r + 5120 + sel * 256); pf_ld(pf[1], r + 5120 + sel * 256 + 128); pf_ld(pf[2], r + 4096 + pr * 512 + sel * 128);
    } else { const int b = unit >> 6, h = (unit >> 4) & 3, c = unit & 15; const unsigned char* r = PROJb + (size_t)(b * SEQ + c * CH + row) * (NPROJ * 2) + h * 256;
        if (kind == 0) { pf_ld(pf[0], r + 1024 + (sel >> 1) * 1024 + (sel & 1) * 128); }
        else { pf_ld(pf[0], r + sel * 1024); pf_ld(pf[1], r + sel * 1024 + 128);
               if (tid < 256) pf_ld(pf[2], p.ws + WS_CTIN + (size_t)unit * 32768 + tid * 128); } }
}
__device__ __forceinline__ void pf_retire(unsigned (&pf)[3]) { asm volatile("s_waitcnt vmcnt(0)" ::: "memory"); asm volatile("" :: "v"(pf[0]), "v"(pf[1]), "v"(pf[2])); }

__device__ __forceinline__ void mlstm_local(const Params& p, LAS unsigned char* lds, int unit, int tid, int lane, int wave, int nkind, int nunit) {
    unsigned char* ws = p.ws;
    const bf16* PROJ = (const bf16*)(ws + WS_PROJ); const float* GATES = (const float*)(ws + WS_GATES);
    bf16* CTLOC = (bf16*)(ws + WS_CTLOC); float* NLOC = (float*)(ws + WS_SMALL); float* MLOC = NLOC + 2 * 65536; float* ACH = MLOC + 512;
    const int b = unit >> 6, h = (unit >> 4) & 3, c = unit & 15, row0 = b * SEQ + c * CH;
    LAS unsigned char* KET = lds + BUF_BYTES; LAS unsigned char* VT = lds + 2 * BUF_BYTES;
    LAS float* s_es = (LAS float*)(lds + SM_OFF);
    const int oct = tid & 15, rg = tid >> 4;
    float y[4][8];
    { v4u rawk[7], rawv[4];
      const float li0 = GATES[(size_t)(row0 + lane) * 8 + h], li1 = GATES[(size_t)(row0 + 64 + lane) * 8 + h], lf0 = GATES[(size_t)(row0 + lane) * 8 + 4 + h], lf1 = GATES[(size_t)(row0 + 64 + lane) * 8 + 4 + h];
      ConvW cw; conv_wload(cw, p.in[7], p.in[8], 512 + h * 128 + oct * 8);
      conv_load(PROJ, row0, 512 + h * 128 + oct * 8, rg, rawk); v_load(PROJ, row0, 1024 + h * 128 + oct * 8, rg, rawv);
      {
          const float b0 = wscan_add(lf0, lane); const float b1 = wscan_add(lf1, lane) + __shfl(b0, 63);
          const float a = __shfl(b1, 63);
          const float w0 = a - b0 + li0, w1 = a - b1 + li1; const float mx = wave_max(fmaxf(w0, w1));
          s_es[lane] = __expf(w0 - mx); s_es[64 + lane] = __expf(w1 - mx);
          if (tid == 0) { MLOC[unit] = mx; ACH[unit] = a; }
          LDS_WAIT(); asm volatile("" ::: "memory"); }
      conv_compute(rawk, cw, c == 0, rg, y);
      v_put_transposed(rawv, rg, oct, VT); }
    { const float sc = 0.08838834764831845f; float rs[4];
#pragma unroll
      for (int rr = 0; rr < 4; ++rr) rs[rr] = s_es[4 * rg + rr] * sc;
      put_transposed<true>(KET, rg, oct, y, rs); }
    __syncthreads();
    unsigned pf[3]; pf_issue(p, nkind, nunit, tid, pf);
    { const int fr = lane & 15, fq = lane >> 4;
      f32x4 acc[8]; zero_acc8(acc);
      lds_mma16(acc, VT, KET, 16 * wave, fr, fq);
      bf16* o = CTLOC + (size_t)unit * 16384 + (16 * wave + fr) * 128 + 8 * fq;
#pragma unroll
      for (int k = 0; k < 4; ++k) { v4u w; w.x = pk2(acc[2 * k][0], acc[2 * k][1]); w.y = pk2(acc[2 * k][2], acc[2 * k][3]); w.z = pk2(acc[2 * k + 1][0], acc[2 * k + 1][1]); w.w = pk2(acc[2 * k + 1][2], acc[2 * k + 1][3]);
          *(v4u*)(o + 32 * k) = w; }
      if (tid < 128) { float s = 0.f;
#pragma unroll
          for (int i = 0; i < 16; ++i) { const v4u w = *(const LAS v4u*)(KET + ypos(tid) * LROW + i * 16); s += (bflo(w.x) + bfhi(w.x)) + (bflo(w.y) + bfhi(w.y)) + (bflo(w.z) + bfhi(w.z)) + (bflo(w.w) + bfhi(w.w)); }
          NLOC[unit * 128 + tid] = s; } }
    pf_retire(pf);
    __syncthreads();
}

__device__ __forceinline__ void gmlp_pair(const Params& p, LAS unsigned char* lds, int unit2, int tid, int lane, int wave, int nkind, int nunit) {
    unsigned char* ws = p.ws;
    const bf16* PROJ = (const bf16*)(ws + WS_PROJ); bf16* MIX = (bf16*)p.out;
    const int b = unit2 >> 5, c = (unit2 >> 1) & 15, pr = unit2 & 1, row0 = b * SEQ + c * CH;
    const int row = tid >> 2, part = tid & 3;
    {
        const int oct = tid & 15, rg = tid >> 4;
        v4u wsv[2][4];
#pragma unroll
        for (int q = 0; q < 2; ++q) { const bf16* wsr = (const bf16*)(ws + WS_WSPB) + ((size_t)(2 * pr + q) * 128 + row) * 128 + part * 32;
#pragma unroll
            for (int i = 0; i < 4; ++i) wsv[q][i] = *(const v4u*)(wsr + i * 8); }
        v4u vv[4][4];
#pragma unroll
        for (int gg = 0; gg < 4; ++gg)
#pragma unroll
            for (int rr = 0; rr < 4; ++rr) vv[gg][rr] = *(const v4u*)(PROJ + (size_t)(row0 + 4 * rg + rr) * NPROJ + 2560 + gg * 128 + oct * 8);
        float mean[4], rstd[4];
#pragma unroll
        for (int rr = 0; rr < 4; ++rr) { float s = 0.f, ss = 0.f;
#pragma unroll
            for (int gg = 0; gg < 4; ++gg) { const v4u w = vv[gg][rr];
                const float x0 = bflo(w.x), x1 = bfhi(w.x), x2 = bflo(w.y), x3 = bfhi(w.y), x4 = bflo(w.z), x5 = bfhi(w.z), x6 = bflo(w.w), x7 = bfhi(w.w);
                s += ((x0 + x1) + (x2 + x3)) + ((x4 + x5) + (x6 + x7)); ss += ((x0 * x0 + x1 * x1) + (x2 * x2 + x3 * x3)) + ((x4 * x4 + x5 * x5) + (x6 * x6 + x7 * x7)); }
            s += __shfl_xor(s, 1); s += __shfl_xor(s, 2); s += __shfl_xor(s, 4); s += __shfl_xor(s, 8);
            ss += __shfl_xor(ss, 1); ss += __shfl_xor(ss, 2); ss += __shfl_xor(ss, 4); ss += __shfl_xor(ss, 8);
            mean[rr] = s * (1.f / 512.f); const float var = fmaxf(ss * (1.f / 512.f) - mean[rr] * mean[rr], 0.f); rstd[rr] = 1.f / sqrtf(var + EPS); }
#pragma unroll
        for (int q = 0; q < 2; ++q) {
            LAS unsigned char* WSB = lds + q * BUF_BYTES; LAS unsigned char* VT = lds + (2 + q) * BUF_BYTES;
            const int cg = (2 * pr + q) * 128 + oct * 8;
            const f32x4 g0 = *(const f32x4*)(p.in[11] + cg), g1 = *(const f32x4*)(p.in[11] + cg + 4), c0 = *(const f32x4*)(p.in[12] + cg), c1 = *(const f32x4*)(p.in[12] + cg + 4);
            v4u own[4];
#pragma unroll
            for (int rr = 0; rr < 4; ++rr) { own[rr] = vv[0][rr];
#pragma unroll
                for (int gg = 1; gg < 4; ++gg) if (gg == 2 * pr + q) own[rr] = vv[gg][rr]; }
#pragma unroll
            for (int e = 0; e < 8; ++e) { float v[4];
#pragma unroll
                for (int rr = 0; rr < 4; ++rr) v[rr] = (bfel(own[rr], e) - mean[rr]) * rstd[rr] * (e < 4 ? g0[e & 3] : g1[e & 3]) + (e < 4 ? c0[e & 3] : c1[e & 3]);
                v2u o; o.x = pk2(v[0], v[1]); o.y = pk2(v[2], v[3]);
                *(LAS v2u*)(VT + ypos(oct * 8 + e) * LROW + rg * 8) = o; }
#pragma unroll
            for (int i = 0; i < 4; ++i) *(LAS v4u*)(WSB + row * LROW + (part * 32 + i * 8) * 2) = wsv[q][i]; }
    }
    __syncthreads();
    unsigned pf[3]; pf_issue(p, nkind, nunit, tid, pf);
    { const int wr2 = wave >> 1, wc2 = wave & 1, fr = lane & 15, fq = lane >> 4;
      v4u uu_[2][2][2]; float bs_[2][2];
#pragma unroll
      for (int q = 0; q < 2; ++q)
#pragma unroll
          for (int m = 0; m < 2; ++m) { const int t = 32 * wr2 + 16 * m + fr; bs_[q][m] = p.in[14][(2 * pr + q) * 128 + t];
#pragma unroll
              for (int k = 0; k < 2; ++k) uu_[q][m][k] = *(const v4u*)(PROJ + (size_t)(row0 + t) * NPROJ + 2048 + (2 * pr + q) * 128 + 64 * wc2 + 32 * k + 8 * fq); }
#pragma unroll
      for (int q = 0; q < 2; ++q) { const int g = 2 * pr + q;
          f32x4 acc[2][4]; zero_acc(acc);
          lds_mma(acc, lds + q * BUF_BYTES, lds + (2 + q) * BUF_BYTES, wr2, wc2, fr, fq);
#pragma unroll
          for (int m = 0; m < 2; ++m) { const int t = 32 * wr2 + 16 * m + fr; const float bs = bs_[q][m];
#pragma unroll
              for (int k = 0; k < 2; ++k) { const int e = 64 * wc2 + 32 * k + 8 * fq;
                  const v4u uu = uu_[q][m][k];
                  const f32x4 s0 = acc[m][2 * k] + bs, s1 = acc[m][2 * k + 1] + bs; v4u o;
                  o.x = pk2(bflo(uu.x) * s0[0], bfhi(uu.x) * s0[1]); o.y = pk2(bflo(uu.y) * s0[2], bfhi(uu.y) * s0[3]);
                  o.z = pk2(bflo(uu.z) * s1[0], bfhi(uu.z) * s1[1]); o.w = pk2(bflo(uu.w) * s1[2], bfhi(uu.w) * s1[3]);
                  *(v4u*)(MIX + (size_t)(row0 + t) * (2 * D) + 512 + g * 128 + e) = o; } } } }
    pf_retire(pf);
    __syncthreads();
}

__device__ __forceinline__ void mlstm_scan(const Params& p, int b, int li, int tid) {
    unsigned char* ws = p.ws;
    const bf16* CTLOC = (const bf16*)(ws + WS_CTLOC); const float* NLOC = (const float*)(ws + WS_SMALL); float* NIN = (float*)(ws + WS_SMALL) + 65536;
    const float* MLOC = NLOC + 2 * 65536; const float* ACH = MLOC + 512; float* MIN = (float*)ACH + 512; bf16* CTIN = (bf16*)(ws + WS_CTIN);
    if (tid < 256) {
        const int g = li * 256 + tid, bh = b * 4 + (g >> 11), idx8 = g & 2047;
        v4u raw[NCH];
#pragma unroll
        for (int c = 0; c < NCH; ++c) raw[c] = *(const v4u*)(CTLOC + (size_t)(bh * 16 + c) * 16384 + idx8 * 8);
        float cs[8]; float mp = 0.f;
#pragma unroll
        for (int i = 0; i < 8; ++i) cs[i] = 0.f;
#pragma unroll
        for (int c = 0; c < NCH; ++c) {
            const int unit = bh * 16 + c;
            v4u o; o.x = pk2(cs[0], cs[1]); o.y = pk2(cs[2], cs[3]); o.z = pk2(cs[4], cs[5]); o.w = pk2(cs[6], cs[7]);
            *(v4u*)(CTIN + (size_t)unit * 16384 + idx8 * 8) = o;
            const float a = ACH[unit], ml = MLOC[unit];
            const float mn = fmaxf(a + mp, ml); const float sp = __expf(a + mp - mn), sl = __expf(ml - mn);
#pragma unroll
            for (int i = 0; i < 8; ++i) cs[i] = cs[i] * sp + bfel(raw[c], i) * sl;
            mp = mn;
        }
    } else if (tid < 272) {
        const int j = li * 16 + (tid - 256), bh = b * 4 + (j >> 7), d = j & 127;
        float nl[NCH];
#pragma unroll
        for (int c = 0; c < NCH; ++c) nl[c] = NLOC[(bh * 16 + c) * 128 + d];
        float ns = 0.f, mp = 0.f;
#pragma unroll
        for (int c = 0; c < NCH; ++c) {
            const int unit = bh * 16 + c;
            NIN[unit * 128 + d] = ns;
            if (d == 0) MIN[unit] = mp;
            const float a = ACH[unit], ml = MLOC[unit];
            const float mn = fmaxf(a + mp, ml); const float sp = __expf(a + mp - mn), sl = __expf(ml - mn);
            ns = ns * sp + nl[c] * sl;
            mp = mn;
        }
    }
}

template <int MODE> __device__ __forceinline__ void mlstm_out(const Params& p, LAS unsigned char* lds, int unit, int tid, int lane, int wave, int nunit) {
    unsigned char* ws = p.ws;
    const bf16* PROJ = (const bf16*)(ws + WS_PROJ); const float* GATES = (const float*)(ws + WS_GATES); bf16* MIX = (bf16*)p.out;
    const float* NIN = (const float*)(ws + WS_SMALL) + 65536; const float* MIN = (const float*)(ws + WS_SMALL) + 2 * 65536 + 1024; const bf16* CTIN = (const bf16*)(ws + WS_CTIN);
    const int b = unit >> 6, h = (unit >> 4) & 3, c = unit & 15, row0 = b * SEQ + c * CH;
    LAS unsigned char* QB = lds; LAS unsigned char* KB = lds + BUF_BYTES; LAS unsigned char* VT = lds + 2 * BUF_BYTES; LAS unsigned char* CT = lds + 3 * BUF_BYTES;
    LAS float* s_g = (LAS float*)(lds + SM_OFF); LAS float* s_u = s_g + 128; LAS float* s_ei = s_g + 256; LAS float* s_fl = s_g + 384;
    LAS unsigned char* NB = lds + SM_OFF + 2048;
    const int oct = tid & 15, rg = tid >> 4, fr = lane & 15, fq = lane >> 4;
    const float m_in = MIN[unit];
    const float li0 = GATES[(size_t)(row0 + lane) * 8 + h], li1 = GATES[(size_t)(row0 + 64 + lane) * 8 + h], lf0 = GATES[(size_t)(row0 + lane) * 8 + 4 + h], lf1 = GATES[(size_t)(row0 + 64 + lane) * 8 + 4 + h];
    { v4u rawq[7], rawk[7], rawv[4], ctr[4];
      ConvW cwq, cwk; conv_wload(cwq, p.in[7], p.in[8], h * 128 + oct * 8); conv_wload(cwk, p.in[7], p.in[8], 512 + h * 128 + oct * 8);
      conv_load(PROJ, row0, h * 128 + oct * 8, rg, rawq); conv_load(PROJ, row0, 512 + h * 128 + oct * 8, rg, rawk); v_load(PROJ, row0, 1024 + h * 128 + oct * 8, rg, rawv);
      { const int r = tid >> 2, q4 = tid & 3; const bf16* src = CTIN + (size_t)unit * 16384 + r * 128 + q4 * 32;
#pragma unroll
        for (int i = 0; i < 4; ++i) ctr[i] = *(const v4u*)(src + i * 8); }
      const f32x4 nin4 = *(const f32x4*)(NIN + unit * 128 + (tid & 31) * 4);
      float y[4][8];
      conv_compute(rawq, cwq, c == 0, rg, y); put_natural(QB, rg, oct, y, 1.0f);
      conv_compute(rawk, cwk, c == 0, rg, y); put_natural(KB, rg, oct, y, 0.08838834764831845f);
      v_put_transposed(rawv, rg, oct, VT);
      { const int r = tid >> 2, q4 = tid & 3;
#pragma unroll
        for (int i = 0; i < 4; ++i) *(LAS v4u*)(CT + r * LROW + q4 * 64 + i * 16) = ctr[i]; }
      { v2u w; w.x = pk2(nin4[0], nin4[1]); w.y = pk2(nin4[2], nin4[3]); *(LAS v2u*)(NB + (tid >> 5) * LROW + (tid & 31) * 8) = w; } }
    {
        const float b0 = wscan_add(lf0, lane); const float b1 = wscan_add(lf1, lane) + __shfl(b0, 63);
        const float g0 = li0 - b0, g1 = li1 - b1;
        const float p0 = wscan_max(g0, lane); const float p1 = fmaxf(wscan_max(g1, lane), __shfl(p0, 63));
        const float mm0 = fmaxf(m_in, p0), mm1 = fmaxf(m_in, p1);
        s_g[lane] = g0; s_g[64 + lane] = g1; s_u[lane] = -mm0; s_u[64 + lane] = -mm1;
        s_ei[lane] = __expf(m_in - mm0); s_ei[64 + lane] = __expf(m_in - mm1);
        s_fl[lane] = __expf(-(b0 + mm0)); s_fl[64 + lane] = __expf(-(b1 + mm1));
    }
    __syncthreads();
    if (MODE == 1) { __syncthreads(); return; }
    const int t = 16 * wave + fr;
    v2u opre[8];
#pragma unroll
    for (int n = 0; n < 8; ++n) opre[n] = *(const v2u*)(PROJ + (size_t)(row0 + t) * NPROJ + 1536 + h * 128 + 16 * n + 4 * fq);
    unsigned pf[3]; pf_issue(p, 2, nunit, tid, pf);
    f32x4 accs[8], acci[8]; zero_acc8(accs); zero_acc8(acci);
    f32x4 accq = (f32x4){0.f, 0.f, 0.f, 0.f};
    lds_mma16(accs, QB, KB, 16 * wave, fr, fq);
    lds_mma16(acci, QB, CT, 16 * wave, fr, fq);
#pragma unroll
    for (int ks = 0; ks < 4; ++ks) { const bf16x8 xa = *(const LAS bf16x8*)(QB + t * LROW + ks * 64 + fq * 16); const bf16x8 nb = *(const LAS bf16x8*)(NB + fr * LROW + ks * 64 + fq * 16);
        accq = __builtin_amdgcn_mfma_f32_16x16x32_bf16(nb, xa, accq, 0, 0, 0); }
    const float ut = s_u[t], ei = s_ei[t], fl = s_fl[t];
    float rsum = 0.f;
    asm volatile("s_waitcnt lgkmcnt(0)" ::: "memory");
#pragma unroll
    for (int n = 0; n < 8; ++n) { const int s0 = 16 * n + 4 * fq; float pv[4];
        const f32x4 gs = *(const LAS f32x4*)(s_g + s0);
#pragma unroll
        for (int r = 0; r < 4; ++r) { const float ev = accs[n][r] * __expf(gs[r] + ut); pv[r] = (s0 + r <= t) ? ev : 0.f; rsum += pv[r]; }
        v2u w; w.x = pk2(pv[0], pv[1]); w.y = pk2(pv[2], pv[3]);
        *(LAS v2u*)(QB + t * LROW + s0 * 2) = w; }
    rsum += __shfl_xor(rsum, 16); rsum += __shfl_xor(rsum, 32);
#pragma unroll
    for (int n = 0; n < 8; ++n) acci[n] = acci[n] * ei;
    asm volatile("s_waitcnt lgkmcnt(0)" ::: "memory");
    lds_mma16(acci, QB, VT, 16 * wave, fr, fq);
    const float den = ei * accq[0] + rsum; const float dv = 1.0f / fmaxf(fabsf(den), fl); float sq = 0.f;
#pragma unroll
    for (int n = 0; n < 8; ++n) { acci[n] = acci[n] * dv; sq += (acci[n][0] * acci[n][0] + acci[n][1] * acci[n][1]) + (acci[n][2] * acci[n][2] + acci[n][3] * acci[n][3]); }
    sq += __shfl_xor(sq, 16); sq += __shfl_xor(sq, 32);
    const float rn = 1.0f / sqrtf(sq * (1.f / 128.f) + EPS);
#pragma unroll
    for (int n = 0; n < 8; ++n) { const int e = 16 * n + 4 * fq;
        const f32x4 gg = *(const f32x4*)(p.in[10] + h * 128 + e);
        const v2u ow = opre[n];
        const float o0 = pg8::fast_sigmoid(bflo(ow.x)), o1 = pg8::fast_sigmoid(bfhi(ow.x)), o2 = pg8::fast_sigmoid(bflo(ow.y)), o3 = pg8::fast_sigmoid(bfhi(ow.y));
        v2u o; o.x = pk2(acci[n][0] * rn * gg[0] * o0, acci[n][1] * rn * gg[1] * o1); o.y = pk2(acci[n][2] * rn * gg[2] * o2, acci[n][3] * rn * gg[3] * o3);
        *(v2u*)(MIX + (size_t)(row0 + t) * (2 * D) + h * 128 + e) = o; }
    pf_retire(pf);
    __syncthreads();
}

__device__ __forceinline__ void gates_phase(const Params& p, LAS unsigned char* lds, int tid, int lane, int wave) {
    unsigned char* ws = p.ws;
    const bf16* XN = (const bf16*)(ws + WS_HS); float* GATES = (float*)(ws + WS_GATES); const float* SS = (const float*)(ws + WS_XCH) + 4 * 65536; const float* g2 = p.in[18] + 2 * D;
    LAS float* WG = (LAS float*)lds;
    const float* w_in = p.in[6];
    { const f32x4* wgt = (const f32x4*)(ws + WS_WGT); (void)w_in; (void)g2;
#pragma unroll
      for (int i = 0; i < 4; ++i) *(LAS f32x4*)(WG + (tid + i * NTHR) * 4) = wgt[tid + i * NTHR]; }
    __syncthreads();
    const int gb_ = blockIdx.x & 7, li_ = blockIdx.x >> 3, NGW = (gridDim.x >> 3) * NWAVES, gw = li_ * NWAVES + wave;
    const int Mb = gb_ * SEQ;
    for (int m0 = Mb + gw; m0 < Mb + SEQ; m0 += 4 * NGW) {
        v4u xa[4], xb[4]; f32x4 s4[4]; float acc[4][8];
#pragma unroll
        for (int r = 0; r < 4; ++r) { const int m = min(m0 + r * NGW, Mb + SEQ - 1); xa[r] = *(const v4u*)(XN + (size_t)m * D + lane * 8); xb[r] = *(const v4u*)(XN + (size_t)m * D + 512 + lane * 8); s4[r] = *(const f32x4*)(SS + (size_t)m * 4); }
#pragma unroll
        for (int r = 0; r < 4; ++r)
#pragma unroll
            for (int j = 0; j < 8; ++j) acc[r][j] = 0.f;
#pragma unroll
        for (int hh = 0; hh < 2; ++hh) {
            float xs[4][8];
#pragma unroll
            for (int r = 0; r < 4; ++r) { const v4u x = hh ? xb[r] : xa[r]; xs[r][0] = bflo(x.x); xs[r][1] = bfhi(x.x); xs[r][2] = bflo(x.y); xs[r][3] = bfhi(x.y); xs[r][4] = bflo(x.z); xs[r][5] = bfhi(x.z); xs[r][6] = bflo(x.w); xs[r][7] = bfhi(x.w); }
#pragma unroll
            for (int j = 0; j < 8; ++j) { const f32x4 w0 = *(const LAS f32x4*)(WG + j * 1024 + hh * 512 + lane * 8), w1 = *(const LAS f32x4*)(WG + j * 1024 + hh * 512 + lane * 8 + 4);
#pragma unroll
                for (int r = 0; r < 4; ++r) acc[r][j] += xs[r][0] * w0[0] + xs[r][1] * w0[1] + xs[r][2] * w0[2] + xs[r][3] * w0[3] + xs[r][4] * w1[0] + xs[r][5] * w1[1] + xs[r][6] * w1[2] + xs[r][7] * w1[3]; } }
#pragma unroll
        for (int r = 0; r < 4; ++r) {
            const bool h5 = (lane & 32) != 0, h4 = (lane & 16) != 0, h3 = (lane & 8) != 0;
            float v4[4], v2[2], v1;
#pragma unroll
            for (int i = 0; i < 4; ++i) { const float keep = h5 ? acc[r][4 + i] : acc[r][i], send = h5 ? acc[r][i] : acc[r][4 + i]; v4[i] = keep + __shfl_xor(send, 32); }
#pragma unroll
            for (int i = 0; i < 2; ++i) { const float keep = h4 ? v4[2 + i] : v4[i], send = h4 ? v4[i] : v4[2 + i]; v2[i] = keep + __shfl_xor(send, 16); }
            { const float keep = h3 ? v2[1] : v2[0], send = h3 ? v2[0] : v2[1]; v1 = keep + __shfl_xor(send, 8); }
            v1 += __shfl_xor(v1, 4); v1 += __shfl_xor(v1, 2); v1 += __shfl_xor(v1, 1);
            const int m = m0 + r * NGW; const int j = (h5 ? 4 : 0) + (h4 ? 2 : 0) + (h3 ? 1 : 0);
            if ((lane & 7) == 0 && m < Mb + SEQ) { float v = v1 * (1.0f / sqrtf(((s4[r][0] + s4[r][1]) + (s4[r][2] + s4[r][3])) * (1.0f / 1024.0f) + EPS));
                v += p.in[9][j];
                if (j >= 4) v = fminf(v, 0.f) - log1pf(expf(-fabsf(v)));
                GATES[(size_t)m * 8 + j] = v; }
        }
    }
    __syncthreads();
}

__global__ void __launch_bounds__(NTHR, 2) mk_fwd(Params p) {
    extern __shared__ __attribute__((aligned(16))) unsigned char lds_raw[];
    cg::grid_group grid = cg::this_grid();
    LAS unsigned char* lds = (LAS unsigned char*)lds_raw;
    const int G = gridDim.x, bx = blockIdx.x;
#define TID_DECL int tid = threadIdx.x; asm volatile("" : "+v"(tid)); const int lane = tid & 63, wave = __builtin_amdgcn_readfirstlane(tid >> 6); (void)lane; (void)wave;
    unsigned char* ws = p.ws;
    unsigned* ctl = (unsigned*)(ws + WS_CTL);
    bf16* WGU1 = (bf16*)(ws + WS_WGU1); bf16* WD1 = (bf16*)(ws + WS_WD1); bf16* WGU2 = (bf16*)(ws + WS_WGU2); bf16* WD2 = (bf16*)(ws + WS_WD2);
    bf16* WIN = (bf16*)(ws + WS_WIN); bf16* WOUT = (bf16*)(ws + WS_WOUT); bf16* WPLE = (bf16*)(ws + WS_WPLE); bf16* WGATE = (bf16*)(ws + WS_WGATE);
    bf16* XN = (bf16*)(ws + WS_XN); bf16* HS = (bf16*)(ws + WS_HS); bf16* HB = (bf16*)(ws + WS_H); bf16* PROJ = (bf16*)(ws + WS_PROJ); bf16* MIX = (bf16*)p.out  ; bf16* EB = (bf16*)(ws + WS_E); bf16* PB = (bf16*)(ws + WS_PB);
    const float* x = p.in[0]; const float* ng = p.in[18]; float* out = p.out;
    unsigned* xch = (unsigned*)(ws + WS_XCH);
    if (threadIdx.x < 4) ((volatile LAS unsigned*)(lds + MISC_OFF))[threadIdx.x] = 0u;
    __syncthreads();
    const XcdBarrier xbar = xcd_barrier_post(ctl + CW_BAR, (volatile LAS unsigned*)(lds + MISC_OFF));
    const GrpBarrier gbar = grp_barrier_post(ctl + 4096, ctl + CW_BAR, (volatile LAS unsigned*)(lds + MISC_OFF) + 2);
#define GBAR() grp_barrier(gbar)
#define GSYNC() xcd_barrier(xbar)
    if (p.out == nullptr) grid.sync();
#define XCH(i) (xch + (size_t)(i) * 65536)
#define SSQ(i) ((float*)(xch + (size_t)(4 + (i)) * 65536))

    {
        TID_DECL
        LAS float* scr = (LAS float*)(lds + wave * 16384);
        const int gw = bx * NWAVES + wave, NGW = G * NWAVES;
        constexpr int I_GU = (D / 64) * (NGU / 32), I_DN = (DFF / 64) * (D / 32), I_IN = (D / 64) * (NPROJ / 32), I_SQ = (D / 64) * (D / 32), I_PL = (DPLE / 64) * (D / 32);
        constexpr int NITEMS = 2 * I_GU + 2 * I_DN + I_IN + 2 * I_SQ + I_PL;
        for (int it = gw; it < NITEMS; it += NGW) {
            int r = it;
            if (r < I_GU) { tr_matrix_item(p.in[2], NGU, D, NGU, WGU1, 1, r, scr, lane, ng); continue; } r -= I_GU;
            if (r < I_GU) { tr_matrix_item(p.in[4], NGU, D, NGU, WGU2, 1, r, scr, lane, ng + 4 * D); continue; } r -= I_GU;
            if (r < I_DN) { tr_matrix_item(p.in[3], D, DFF, D, WD1, 0, r, scr, lane); continue; } r -= I_DN;
            if (r < I_DN) { tr_matrix_item(p.in[5], D, DFF, D, WD2, 0, r, scr, lane); continue; } r -= I_DN;
            if (r < I_IN) { tr_matrix_item(p.in[6], INC, D, NPROJ, WIN, 2, r, scr, lane, ng + 2 * D); continue; } r -= I_IN;
            if (r < I_SQ) { tr_matrix_item(p.in[15], D, D, D, WOUT, 0, r, scr, lane); continue; } r -= I_SQ;
            if (r < I_SQ) { tr_matrix_item(p.in[17], D, D, D, WGATE, 0, r, scr, lane, ng + 6 * D); continue; } r -= I_SQ;
            tr_matrix_item(p.in[16], D, DPLE, D, WPLE, 0, r, scr, lane);
        }
        { const int gi = bx * NTHR + tid - 8192;
          if (gi >= 0 && gi < 8192) { const int k = gi >> 3, j = gi & 7; ((float*)(ws + WS_WGT))[j * 1024 + k] = p.in[6][(size_t)k * INC + 2048 + j] * ng[2 * D + k]; } }
        { const int gi = bx * NTHR + tid;
          if (gi < 8192) { const int t = (gi >> 4) & 127, s0 = (gi & 15) * 8; const float* src = p.in[13] + (size_t)gi * 8; const f32x4 a = *(const f32x4*)src, b = *(const f32x4*)(src + 4);
              float v[8] = {a[0], a[1], a[2], a[3], b[0], b[1], b[2], b[3]};
#pragma unroll
              for (int e = 0; e < 8; ++e) if (s0 + e > t) v[e] = 0.f;
              v4u w; w.x = pk2(v[0], v[1]); w.y = pk2(v[2], v[3]); w.z = pk2(v[4], v[5]); w.w = pk2(v[6], v[7]);
              *(v4u*)((bf16*)(ws + WS_WSPB) + (size_t)gi * 8) = w; } }
        for (int m = gw; m < M; m += 2 * NGW) x_row2_to_bf16(x + (size_t)m * D, x + (size_t)(m + NGW) * D, HS + (size_t)m * D, HS + (size_t)(m + NGW) * D, SSQ(3) + (size_t)m * 4, SSQ(3) + (size_t)(m + NGW) * 4, lane);
        const float* pp = p.in[1];
        { constexpr int NP = M * DPLE / 8, STEP = NP / 4;
          for (int i = bx * NTHR + tid; i < STEP; i += G * NTHR) { f32x4 a[4], b[4];
#pragma unroll
              for (int q = 0; q < 4; ++q) { a[q] = *(const f32x4*)(pp + (size_t)(i + q * STEP) * 8); b[q] = *(const f32x4*)(pp + (size_t)(i + q * STEP) * 8 + 4); }
#pragma unroll
              for (int q = 0; q < 4; ++q) { v4u w; w.x = pk2(a[q][0], a[q][1]); w.y = pk2(a[q][2], a[q][3]); w.z = pk2(b[q][0], b[q][1]); w.w = pk2(b[q][2], b[q][3]); *(v4u*)(PB + (size_t)(i + q * STEP) * 8) = w; } } }
    }
    GSYNC();

    { pg8::Gemm g{HS, WGU1, M, NGU, D}; pg8::StaticOrder S; S.init(M, NGU, G, bx); pg8::EpiSwiglu E{HB, NPROJ  , SSQ(3), -1, {}};
      pg8::gemm_phase<pg8::EpiSwiglu, pg8::StaticOrder, true, true>(lds, g, S, E); }
    { const int nh = G / 2;
      pg8::Gemm g{PB, WPLE, M, D, DPLE}; pg8::StaticOrder S; S.init(M, D, G - nh, bx >= nh ? bx - nh : (1 << 24)); pg8::EpiProj E{EB, D, 1 << 30, nullptr, -1, {}, true};
      pg8::gemm_phase<pg8::EpiProj, pg8::StaticOrder, true, true>(lds, g, S, E); }
    GBAR();

    { pg8::Gemm g{HB, WD1, M, D, DFF, NPROJ}; pg8::StaticOrder S; S.init(M, D, G, bx);
      pg8::RmsStats s1{XCH(0), EPS};
      pg8::EpiRmsRes E{nullptr, HS, HS, ng + 1 * D, 0.5f, SSQ(0), s1};
      pg8::gemm_phase<pg8::EpiRmsRes, pg8::StaticOrder, false, true>(lds, g, S, E); }
    GBAR();

    {
    { TID_DECL gates_phase(p, lds, tid, lane, wave); }
    { pg8::Gemm g{HS, WIN, M, NPROJ, D}; pg8::StaticOrder S; S.init(M, NPROJ, G, bx); pg8::EpiProj E{PROJ, NPROJ, 8, SSQ(0), -1, {}, false};
      pg8::gemm_phase<pg8::EpiProj, pg8::StaticOrder, true, true>(lds, g, S, E); } }
    GBAR();

    {
    for (int k = 0; k < 3; ++k) { TID_DECL
        const int b_ = bx & 7, li = bx >> 3;
        if (k == 0) mlstm_local(p, lds, b_ * 64 + li, tid, lane, wave, 0, b_ * 64 + li + 32);
        else if (k == 1) mlstm_local(p, lds, b_ * 64 + li + 32, tid, lane, wave, 1, b_ * 32 + li);
        else gmlp_pair(p, lds, b_ * 32 + li, tid, lane, wave, 1, -1); }
    GBAR();

    { TID_DECL mlstm_scan(p, bx & 7, bx >> 3, tid); }
    GBAR();

    for (int k = 0; k < 2; ++k) { TID_DECL const int u = (bx & 7) * 64 + (bx >> 3) + 32 * k; mlstm_out<0>(p, lds, u, tid, lane, wave, k == 0 ? u + 32 : -1); }
    GBAR();
    }

    { pg8::Gemm g{MIX, WOUT, M, D, D, 2 * D}  ; pg8::StaticOrder S; S.init(M, D, G, bx);
      pg8::RmsStats s1{XCH(1), EPS};
      pg8::EpiRmsRes E{nullptr, HS, HS, ng + 3 * D, 1.0f, SSQ(1), s1};
      pg8::gemm_phase<pg8::EpiRmsRes, pg8::StaticOrder, false, true>(lds, g, S, E); }
    GBAR();

    { pg8::Gemm g{HS, WGU2, M, NGU, D}; pg8::StaticOrder S; S.init(M, NGU, G, bx); pg8::EpiSwiglu E{HB, NPROJ  , SSQ(1), -1, {}};
      pg8::gemm_phase<pg8::EpiSwiglu, pg8::StaticOrder, true, true>(lds, g, S, E); }
    GBAR();

    { pg8::Gemm g{HB, WD2, M, D, DFF, NPROJ}; pg8::StaticOrder S; S.init(M, D, G, bx);
      pg8::RmsStats s1{XCH(2), EPS};
      pg8::EpiRmsRes E{nullptr, HS, HS, ng + 5 * D, 0.5f, SSQ(2), s1};
      pg8::gemm_phase<pg8::EpiRmsRes, pg8::StaticOrder, false, true>(lds, g, S, E); }
    GBAR();

    { pg8::Gemm g{HS, WGATE, M, D, D}; pg8::StaticOrder S; S.init(M, D, G, bx);
      pg8::RmsStats s1{XCH(3), EPS};
      pg8::EpiGateRms E{HS, out, EB, ng + 7 * D, SSQ(2), s1};
      pg8::gemm_phase<pg8::EpiGateRms, pg8::StaticOrder, false, true>(lds, g, S, E); }
}

extern "C" void kernel_launch(void* const* d_in, const int* in_sizes, int n_in, void* d_out, int out_size, void* d_ws, size_t ws_size, hipStream_t stream) {
    static int grid = 0;
    if (grid == 0) {
        int dev = 0, cus = 0, per_cu = 0;
        hipGetDevice(&dev);
        hipDeviceGetAttribute(&cus, hipDeviceAttributeMultiprocessorCount, dev);
        hipFuncSetAttribute((const void*)mk_fwd, hipFuncAttributeMaxDynamicSharedMemorySize, LDS_BYTES);
        hipOccupancyMaxActiveBlocksPerMultiprocessor(&per_cu, (const void*)mk_fwd, NTHR, LDS_BYTES);
        if (per_cu < 1) { fprintf(stderr, "kernel_launch: occupancy query says %d blocks/CU\n", per_cu); per_cu = 1; }
        (void)hipGetLastError();
        grid = cus;
        if (grid != 256) fprintf(stderr, "kernel_launch: %d CUs; the fused epilogues need exactly 256 workgroups\n", grid);
    }
    hipMemsetAsync((char*)d_ws + WS_ZERO, 0, ZERO_BYTES, stream);
    Params p{};
    for (int i = 0; i < 19; ++i) p.in[i] = (const float*)d_in[i];
    p.out = (float*)d_out; p.ws = (unsigned char*)d_ws;
    void* args[] = {&p};
    hipError_t e = hipLaunchCooperativeKernel((const void*)mk_fwd, dim3(grid), dim3(NTHR), args, LDS_BYTES, stream);
    if (e != hipSuccess) fprintf(stderr, "cooperative launch failed: %s (grid %d)\n", hipGetErrorString(e), grid);
}
```
